# Optimizing an MI355X kernel written in HIP

```python
import math
import jax, jax.numpy as jnp
from jax import lax
import numpy as np

D_MODEL = 1024
BATCH = 16
SEQ = 256
DEPTH = 4
DEC_BATCH = 4
DEC_SEQ = 1024
PAST_LEN = 512

GRID_W = 64
N_EVEN = (DEPTH + 1) // 2
N_ODD = DEPTH // 2
SSD_HEADS = 16
SSD_HD = 64
SSD_INNER = SSD_HEADS * SSD_HD
SSD_GROUPS = 4
HEADS_PER_GROUP = SSD_HEADS // SSD_GROUPS
D_STATE = 128
CONV_W = 5
CONV_CH = SSD_INNER + 2 * SSD_GROUPS * D_STATE
CHUNK = 128
ATT_HEADS = 8
ATT_HD = 64
ATT_VD = 2 * ATT_HD
ATT_INNER = ATT_HEADS * ATT_VD
Q_BLOCK = 128
ROPE_THETA = 10000.0
ROPE_PAIRS = ATT_HD // 4
FOUR_GROUPS = 4
FFN_HIDDEN = -(-8 * D_MODEL // (3 * 256)) * 256
IN_AB = SSD_INNER + CONV_CH + 2 * SSD_HEADS + 3 * ATT_INNER
OUT_AB = SSD_INNER + ATT_INNER
EPS = 1e-6

kernel_name = "hybrid_ssd_diffattn_fnet_diffusion_step"


def rmsnorm(x, g):
    xf = x.astype(jnp.float32)
    y = xf * lax.rsqrt(jnp.mean(xf * xf, axis=-1, keepdims=True) + EPS)
    return (y * g.astype(jnp.float32)).astype(x.dtype)


def modulate(x, g, shift, scale):
    return rmsnorm(x, g) * (1 + scale) + shift


def depthwise_conv(x, w, b):
    y = lax.conv_general_dilated(
        x, w.astype(x.dtype)[:, None, :], window_strides=(1,),
        padding=[(CONV_W // 2, CONV_W // 2)],
        dimension_numbers=("NWC", "WIO", "NWC"),
        feature_group_count=x.shape[-1])
    return y + b


def ssd_scan(x, dt, a, bm, cm, h0):
    bsz, L = x.shape[:2]
    q = math.gcd(L, CHUNK)
    nc = L // q
    G, R, P, N = SSD_GROUPS, HEADS_PER_GROUP, SSD_HD, D_STATE
    xf = x.astype(jnp.float32).reshape(bsz, nc, q, G, R, P)
    dtc = dt.reshape(bsz, nc, q, G, R)
    bc = bm.astype(jnp.float32).reshape(bsz, nc, q, G, N)
    cc = cm.astype(jnp.float32).reshape(bsz, nc, q, G, N)
    acs = jnp.cumsum(dtc * a, axis=2)
    seg = acs[:, :, :, None] - acs[:, :, None, :]
    lower = jnp.tril(jnp.ones((q, q), dtype=bool))[None, None, :, :, None, None]
    decay = jnp.exp(jnp.where(lower, seg, -jnp.inf))
    cb = jnp.einsum("bcign,bcjgn->bcijg", cc, bc)
    w_ij = cb[..., None] * decay * dtc[:, :, None]
    y_in = jnp.einsum("bcijgr,bcjgrp->bcigrp", w_ij, xf)
    to_end = jnp.exp(acs[:, :, -1:] - acs) * dtc
    st = jnp.einsum("bcjgrp,bcjgn->bcgrpn", to_end[..., None] * xf, bc)
    chunk_decay = jnp.exp(acs[:, :, -1])

    def step(h, inp):
        dec, s = inp
        return dec[..., None, None] * h + s, h

    h_last, h_prev = lax.scan(step, h0.astype(jnp.float32),
                              (jnp.moveaxis(chunk_decay, 1, 0), jnp.moveaxis(st, 1, 0)))
    h_prev = jnp.moveaxis(h_prev, 0, 1)
    y_out = jnp.einsum("bcign,bcgrpn->bcigrp", cc, h_prev) * jnp.exp(acs)[..., None]
    return (y_in + y_out).reshape(bsz, L, G, R, P), h_last


def rope_tables(L):
    rows = L // GRID_W
    t = jnp.arange(rows * GRID_W)
    row = (t // GRID_W).astype(jnp.float32)
    col = (t % GRID_W).astype(jnp.float32)
    freq = ROPE_THETA ** (-jnp.arange(ROPE_PAIRS, dtype=jnp.float32) / ROPE_PAIRS)
    ar = row[:, None] * freq[None]
    ac = col[:, None] * freq[None]
    return (jnp.cos(ar), jnp.sin(ar), jnp.cos(ac), jnp.sin(ac))


def _rot(x, cos, sin):
    a, b = x[..., :ROPE_PAIRS], x[..., ROPE_PAIRS:]
    cos = cos[None, :, None, None, :]
    sin = sin[None, :, None, None, :]
    return jnp.concatenate([a * cos - b * sin, a * sin + b * cos], axis=-1)


def rope2d(x, rope):
    cr, sr, ccol, scol = rope
    half = ATT_HD // 2
    return jnp.concatenate([_rot(x[..., :half], cr, sr), _rot(x[..., half:], ccol, scol)],
                           axis=-1).astype(x.dtype)


def diff_attend(q, k, v, lam):
    bsz, lq = q.shape[:2]
    blk = math.gcd(lq, Q_BLOCK)
    nb = lq // blk
    qb = jnp.moveaxis(q.reshape(bsz, nb, blk, ATT_HEADS, 2, ATT_HD), 1, 0)
    scale = ATT_HD ** -0.5

    def one(qblk):
        s = jnp.einsum("bqhmd,bkhmd->bhmqk", qblk, k).astype(jnp.float32) * scale
        p = jax.nn.softmax(s, axis=-1)
        pd = p[:, :, 0] - lam * p[:, :, 1]
        return jnp.einsum("bhqk,bkhe->bqhe", pd.astype(v.dtype), v)

    o = lax.map(one, qb)
    return jnp.moveaxis(o, 0, 1).reshape(bsz, lq, ATT_HEADS, ATT_VD)


def ab_mixer(h, w_in, conv_w, conv_b, dt_bias, a_log, d_skip, ssd_norm, lam_qk, subln,
             w_out, lambda_init, h0_f, h0_b, ctx_k=None, ctx_v=None, rope=None):
    bsz, L, _ = h.shape
    G, R, P, N = SSD_GROUPS, HEADS_PER_GROUP, SSD_HD, D_STATE
    proj = h @ w_in
    o1 = SSD_INNER
    o2 = o1 + CONV_CH
    o3 = o2 + 2 * SSD_HEADS
    o4 = o3 + ATT_INNER
    o5 = o4 + ATT_INNER
    z, xbc, dt_raw, q, k, v = jnp.split(proj, [o1, o2, o3, o4, o5], axis=-1)

    xbc = jax.nn.silu(depthwise_conv(xbc, conv_w, conv_b))
    xs, bm, cm = jnp.split(xbc, [SSD_INNER, SSD_INNER + G * N], axis=-1)
    xs = xs.reshape(bsz, L, G, R, P)
    bm = bm.reshape(bsz, L, G, N)
    cm = cm.reshape(bsz, L, G, N)
    dt = jax.nn.softplus(dt_raw.astype(jnp.float32).reshape(bsz, L, 2, SSD_HEADS)
                         + dt_bias.astype(jnp.float32)).reshape(bsz, L, 2, G, R)
    a = -jnp.exp(a_log.astype(jnp.float32)).reshape(2, G, R)
    y_f, hf = ssd_scan(xs, dt[:, :, 0], a[0], bm, cm, h0_f.reshape(bsz, G, R, P, N))
    y_b, hb = ssd_scan(jnp.flip(xs, 1), jnp.flip(dt[:, :, 1], 1), a[1],
                       jnp.flip(bm, 1), jnp.flip(cm, 1), h0_b.reshape(bsz, G, R, P, N))
    y = y_f + jnp.flip(y_b, 1) + d_skip.reshape(G, R)[..., None] * xs
    y = y.reshape(bsz, L, SSD_INNER).astype(h.dtype)
    y_ssd = rmsnorm(y * jax.nn.silu(z), ssd_norm)

    q = q.reshape(bsz, L, ATT_HEADS, 2, ATT_HD)
    k = k.reshape(bsz, L, ATT_HEADS, 2, ATT_HD)
    v = v.reshape(bsz, L, ATT_HEADS, ATT_VD)
    if rope is not None:
        q_att = rope2d(q, rope)
        k_att = rope2d(k, rope)
    else:
        q_att, k_att = q, k
    if ctx_k is not None:
        k_all = jnp.concatenate([ctx_k.astype(k_att.dtype), k_att], axis=1)
        v_all = jnp.concatenate([ctx_v.astype(v.dtype), v], axis=1)
    else:
        k_all, v_all = k_att, v
    lq = lam_qk.astype(jnp.float32)
    lam = jnp.exp(jnp.sum(lq[0] * lq[1])) - jnp.exp(jnp.sum(lq[2] * lq[3])) + lambda_init
    o = diff_attend(q_att, k_all, v_all, lam)
    o = rmsnorm(o, subln) * (1.0 - lambda_init)

    out = jnp.concatenate([y_ssd, o.reshape(bsz, L, ATT_INNER)], axis=-1) @ w_out
    hf = hf.reshape(bsz, SSD_HEADS, P, N).astype(h.dtype)
    hb = hb.reshape(bsz, SSD_HEADS, P, N).astype(h.dtype)
    return out, k, v, hf, hb


def fourier_mix(h, w, b):
    bsz, L, D = h.shape
    hg = h.reshape(bsz, L, FOUR_GROUPS, D // FOUR_GROUPS).astype(jnp.float32)
    f = jnp.fft.fftn(hg, axes=(1, 3), norm="ortho").real
    return f.reshape(bsz, L, D).astype(h.dtype) @ w + b


def swiglu(h, w_in, w_out):
    g, u = jnp.split(h @ w_in, 2, axis=-1)
    return (jax.nn.silu(g) * u) @ w_out


def setup_inputs(seed: int = 0) -> dict:
    key = jax.random.key(seed)
    ks = jax.random.split(key, 32)
    f32 = jnp.float32

    def nrm(k, shape, scale):
        return jax.random.normal(k, shape, f32) * scale

    dt0 = jnp.exp(jax.random.uniform(ks[12], (N_EVEN, 2, SSD_HEADS), f32,
                                     math.log(1e-3), math.log(1e-1)))
    dt_bias = dt0 + jnp.log(-jnp.expm1(-dt0))
    a_log = jnp.log(jax.random.uniform(ks[13], (N_EVEN, 2, SSD_HEADS), f32, 1.0, 16.0))
    return {
        "x_prompt": nrm(ks[0], (BATCH, SEQ, D_MODEL), 1.0),
        "x_sample": nrm(ks[1], (DEC_BATCH, DEC_SEQ, D_MODEL), 1.0),
        "cache_k": nrm(ks[2], (DEC_BATCH, N_EVEN, PAST_LEN, ATT_HEADS, 2, ATT_HD), 1.0),
        "cache_v": nrm(ks[3], (DEC_BATCH, N_EVEN, PAST_LEN, ATT_HEADS, ATT_VD), 1.0),
        "state_ssd_fwd": nrm(ks[4], (DEC_BATCH, N_EVEN, SSD_HEADS, SSD_HD, D_STATE), 0.05),
        "state_ssd_bwd": nrm(ks[5], (DEC_BATCH, N_EVEN, SSD_HEADS, SSD_HD, D_STATE), 0.05),
        "c": nrm(ks[6], (DEC_BATCH, D_MODEL), 1.0),
        "c_ctx": nrm(ks[7], (D_MODEL,), 1.0),
        "w_ada": nrm(ks[8], (DEPTH, D_MODEL, 6 * D_MODEL), 0.5 * D_MODEL ** -0.5),
        "b_ada": nrm(ks[9], (DEPTH, 6 * D_MODEL), 0.01),
        "norm_mix": 1.0 + nrm(ks[10], (DEPTH, D_MODEL), 0.02),
        "norm_ffn": 1.0 + nrm(ks[11], (DEPTH, D_MODEL), 0.02),
        "w_in_ab": nrm(ks[14], (N_EVEN, D_MODEL, IN_AB), D_MODEL ** -0.5),
        "conv_w": nrm(ks[15], (N_EVEN, CONV_W, CONV_CH), CONV_W ** -0.5),
        "conv_b": nrm(ks[16], (N_EVEN, CONV_CH), 0.02),
        "dt_bias": dt_bias,
        "a_log": a_log,
        "d_skip": 1.0 + nrm(ks[17], (N_EVEN, SSD_HEADS), 0.1),
        "ssd_norm": 1.0 + nrm(ks[18], (N_EVEN, SSD_INNER), 0.02),
        "lambda_qk": nrm(ks[19], (N_EVEN, 4, ATT_HD), 0.1),
        "subln": 1.0 + nrm(ks[20], (N_EVEN, ATT_VD), 0.02),
        "w_out_ab": nrm(ks[21], (N_EVEN, OUT_AB, D_MODEL), OUT_AB ** -0.5),
        "w_four": nrm(ks[22], (N_ODD, D_MODEL, D_MODEL), D_MODEL ** -0.5),
        "b_four": nrm(ks[23], (N_ODD, D_MODEL), 0.01),
        "w_ffn_in": nrm(ks[24], (DEPTH, D_MODEL, 2 * FFN_HIDDEN), D_MODEL ** -0.5),
        "w_ffn_out": nrm(ks[25], (DEPTH, FFN_HIDDEN, D_MODEL), FFN_HIDDEN ** -0.5),
        "norm_final": 1.0 + nrm(ks[26], (D_MODEL,), 0.02),
    }


def reference(x_prompt, x_sample, cache_k, cache_v, state_ssd_fwd, state_ssd_bwd, c, c_ctx,
              w_ada, b_ada, norm_mix, norm_ffn, w_in_ab, conv_w, conv_b, dt_bias, a_log,
              d_skip, ssd_norm, lambda_qk, subln, w_out_ab, w_four, b_four, w_ffn_in,
              w_ffn_out, norm_final):
    xp, xs = x_prompt, x_sample
    bp = xp.shape[0]
    rope = rope_tables(xs.shape[1])
    silu_ctx = jax.nn.silu(c_ctx)
    silu_c = jax.nn.silu(c)
    zero_state = jnp.zeros((bp, SSD_HEADS, SSD_HD, D_STATE), xp.dtype)
    new_k, new_v, new_f, new_b = [], [], [], []
    for l in range(DEPTH):
        mp = silu_ctx @ w_ada[l] + b_ada[l]
        ms = (silu_c @ w_ada[l] + b_ada[l])[:, None, :]
        sh1p, sc1p, g1p, sh2p, sc2p, g2p = jnp.split(mp, 6, axis=-1)
        sh1s, sc1s, g1s, sh2s, sc2s, g2s = jnp.split(ms, 6, axis=-1)
        hp = modulate(xp, norm_mix[l], sh1p, sc1p)
        hs = modulate(xs, norm_mix[l], sh1s, sc1s)
        if l % 2 == 0:
            e = l // 2
            lambda_init = 0.8 - 0.6 * math.exp(-0.3 * l)
            w = (w_in_ab[e], conv_w[e], conv_b[e], dt_bias[e], a_log[e], d_skip[e],
                 ssd_norm[e], lambda_qk[e], subln[e], w_out_ab[e], lambda_init)
            op, kp, vp, hfp, hbp = ab_mixer(hp, *w, zero_state, zero_state)
            os_, _, _, _, _ = ab_mixer(hs, *w, state_ssd_fwd[:, e], state_ssd_bwd[:, e],
                                       cache_k[:, e], cache_v[:, e], rope)
            new_k.append(kp)
            new_v.append(vp)
            new_f.append(hfp)
            new_b.append(hbp)
        else:
            o_i = l // 2
            op = fourier_mix(hp, w_four[o_i], b_four[o_i])
            os_ = fourier_mix(hs, w_four[o_i], b_four[o_i])
        xp = xp + g1p * op
        xs = xs + g1s * os_
        xp = xp + g2p * swiglu(modulate(xp, norm_ffn[l], sh2p, sc2p), w_ffn_in[l], w_ffn_out[l])
        xs = xs + g2s * swiglu(modulate(xs, norm_ffn[l], sh2s, sc2s), w_ffn_in[l], w_ffn_out[l])
    y_prompt = rmsnorm(xp, norm_final)
    y_sample = rmsnorm(xs, norm_final)
    return (y_prompt, y_sample, jnp.stack(new_k, axis=1), jnp.stack(new_v, axis=1),
            jnp.stack(new_f, axis=1), jnp.stack(new_b, axis=1))
```

```cpp
#include <hip/hip_runtime.h>
#include <hip/hip_cooperative_groups.h>
#include <cstdio>
namespace cg = cooperative_groups;

#ifndef USE_COOP
#define USE_COOP 1
#endif

typedef unsigned short bf16_t;
typedef short bf16x8 __attribute__((ext_vector_type(8)));
typedef float f32x4 __attribute__((ext_vector_type(4)));
#define DEVI __device__ __forceinline__
#define LAS __attribute__((address_space(3)))

constexpr int T_ALL = 8192;
constexpr int D = 1024;
constexpr int NIN = 6272;
constexpr int FH = 2816;
constexpr int LDS_BYTES = 73728;
constexpr int NPHASE = 34;

constexpr size_t OFF_WTIN   = 0;
constexpr size_t OFF_WTOUT  = OFF_WTIN   + 2ull * NIN * 1024 * 2;
constexpr size_t OFF_WTFOUR = OFF_WTOUT  + 2ull * 1024 * 2048 * 2;
constexpr size_t OFF_WTFIN  = OFF_WTFOUR + 2ull * 1024 * 1024 * 2;
constexpr size_t OFF_WTFOUT = OFF_WTFIN  + 4ull * 5632 * 1024 * 2;
constexpr size_t OFF_DL1024 = OFF_WTFOUT + 4ull * 1024 * 2816 * 2;
constexpr size_t OFF_DL256  = OFF_DL1024 + 1024ull * 2048 * 2;
constexpr size_t OFF_DC     = OFF_DL256  + 256ull * 512 * 2;
constexpr size_t OFF_ROPE   = OFF_DC     + 512ull * 256 * 2;
constexpr size_t OFF_MOD    = OFF_ROPE   + 64 * 16 * 2 * 4;
constexpr size_t OFF_LAM    = OFF_MOD    + 4ull * 5 * 6144 * 4;
constexpr size_t OFF_X      = OFF_LAM    + 256;
constexpr size_t OFF_HBF    = OFF_X      + 8192ull * 1024 * 4;
constexpr size_t OFF_Z      = OFF_HBF    + 8192ull * 1024 * 2;
constexpr size_t OFF_XBC    = OFF_Z      + 8192ull * 1024 * 2;
constexpr size_t OFF_Q      = OFF_XBC    + 8192ull * 2048 * 2;
constexpr size_t OFF_KP     = OFF_Q      + 8192ull * 1024 * 2;
constexpr size_t OFF_KS     = OFF_KP     + 16ull * 8 * 256 * 128 * 2;
constexpr size_t OFF_VTP    = OFF_KS     + 4ull * 8 * 1536 * 128 * 2;
constexpr size_t OFF_VTS    = OFF_VTP    + 16ull * 8 * 128 * 256 * 2;
constexpr size_t OFF_XBCC   = OFF_VTS    + 4ull * 8 * 128 * 1536 * 2;
constexpr size_t OFF_DTRAW  = OFF_XBCC   + 8192ull * 2048 * 2;
constexpr size_t OFF_DT     = OFF_DTRAW  + 8192ull * 32 * 4;
constexpr size_t OFF_OCAT   = OFF_DT     + 8192ull * 32 * 4;
constexpr size_t OFF_BAR    = OFF_OCAT   + 8192ull * 2048 * 2;
constexpr size_t WS_END     = OFF_BAR    + 16384;
constexpr size_t OFF_HID  = OFF_Z;
constexpr size_t OFF_F    = OFF_Z;
constexpr size_t OFF_UVTP = OFF_XBC;
constexpr size_t OFF_UVTS = OFF_XBC + 16ull * 1024 * 512 * 2;
constexpr size_t OFF_YF   = OFF_XBC;
constexpr size_t OFF_YB   = OFF_XBC + 8192ull * 1024 * 2;

struct P {
    const float *x_prompt, *x_sample, *cache_k, *cache_v, *st_f, *st_b, *c, *c_ctx, *w_ada, *b_ada, *norm_mix, *norm_ffn,
        *w_in_ab, *conv_w, *conv_b, *dt_bias, *a_log, *d_skip, *ssd_norm, *lambda_qk, *subln, *w_out_ab, *w_four, *b_four,
        *w_ffn_in, *w_ffn_out, *norm_final;
    float* out;
    char* ws;
};

typedef __bf16 bf16v2_t __attribute__((ext_vector_type(2)));
typedef float f32v2_t __attribute__((ext_vector_type(2)));
DEVI unsigned pack2(float a, float b) { f32v2_t v = {a, b}; bf16v2_t r = __builtin_convertvector(v, bf16v2_t); return __builtin_bit_cast(unsigned, r); }
DEVI bf16_t f2bf(float f) { return (bf16_t)(pack2(f, f) & 0xffffu); }
DEVI float bf2f(bf16_t h) { return __uint_as_float(((unsigned)h) << 16); }
DEVI float siluf(float x) { return x / (1.f + __expf(-x)); }
DEVI int rowgrp(int r) { return r < 4096 ? 0 : 1 + ((r - 4096) >> 10); }
DEVI float wave_sum(float v) {
#pragma unroll
    for (int o = 32; o > 0; o >>= 1) v += __shfl_xor(v, o);
    return v;
}
template <int CTRL> DEVI float dpp_f(float v) { return __int_as_float(__builtin_amdgcn_update_dpp(0, __float_as_int(v), CTRL, 0xf, 0xf, true)); }
DEVI float q16_sum(float v) {
#pragma unroll
    for (int o = 8; o > 0; o >>= 1) v += __shfl_xor(v, o);
    return v;
}
DEVI float q16_max(float v) {
#pragma unroll
    for (int o = 8; o > 0; o >>= 1) v = fmaxf(v, __shfl_xor(v, o));
    return v;
}
DEVI f32x4 mfma16(bf16x8 a, bf16x8 b, f32x4 c) { return __builtin_amdgcn_mfma_f32_16x16x32_bf16(a, b, c, 0, 0, 0); }
DEVI bf16x8 lds_frag(const bf16_t* p) { return *(const bf16x8*)p; }

template <class Epi>
DEVI void gemm_tile(const bf16_t* __restrict__ A, int lda, const bf16_t* __restrict__ Bt, int ldb, int K, char* smem, const Epi& epi,
                    const bf16_t* An = nullptr, const bf16_t* Btn = nullptr, bool pre = false) {
    const int tid = threadIdx.x, lane = tid & 63, w = tid >> 6, wr = w >> 1, wc = w & 1, l15 = lane & 15, quad = lane >> 4;
    bf16_t* As = (bf16_t*)smem;
    bf16_t* Bs = As + 2 * 128 * 64;
    f32x4 acc[4][4];
#pragma unroll
    for (int i = 0; i < 4; ++i)
#pragma unroll
        for (int j = 0; j < 4; ++j) acc[i][j] = (f32x4){0.f, 0.f, 0.f, 0.f};
    const int lr = tid >> 3, lc = (tid & 7) * 8;
    const int wofs = lr * 64 + (((tid & 7) ^ ((lr >> 1) & 7)) * 8);
    const bf16_t* Ag = A + (size_t)lr * lda + lc;
    const bf16_t* Bg = Bt + (size_t)lr * ldb + lc;
    uint4 a00, a01, a02, a03, b00, b01, b02, b03, a10, a11, a12, a13, b10, b11, b12, b13;
#define G_LOADP(S, AP, BP) { const bf16_t* ap_ = (AP); const bf16_t* bp_ = (BP); \
        a##S##0 = *(const uint4*)(ap_); a##S##1 = *(const uint4*)(ap_ + (size_t)32 * lda); a##S##2 = *(const uint4*)(ap_ + (size_t)64 * lda); a##S##3 = *(const uint4*)(ap_ + (size_t)96 * lda); \
        b##S##0 = *(const uint4*)(bp_); b##S##1 = *(const uint4*)(bp_ + (size_t)32 * ldb); b##S##2 = *(const uint4*)(bp_ + (size_t)64 * ldb); b##S##3 = *(const uint4*)(bp_ + (size_t)96 * ldb); }
#define G_LOAD(S, KT) { const size_t k0_ = (size_t)((KT) << 6); \
        a##S##0 = *(const uint4*)(Ag + k0_); a##S##1 = *(const uint4*)(Ag + (size_t)32 * lda + k0_); a##S##2 = *(const uint4*)(Ag + (size_t)64 * lda + k0_); a##S##3 = *(const uint4*)(Ag + (size_t)96 * lda + k0_); \
        b##S##0 = *(const uint4*)(Bg + k0_); b##S##1 = *(const uint4*)(Bg + (size_t)32 * ldb + k0_); b##S##2 = *(const uint4*)(Bg + (size_t)64 * ldb + k0_); b##S##3 = *(const uint4*)(Bg + (size_t)96 * ldb + k0_); }
#define L_STORE(S, BUF) { bf16_t* Aw_ = As + (BUF) * 128 * 64 + wofs; bf16_t* Bw_ = Bs + (BUF) * 128 * 64 + wofs; \
        *(uint4*)(Aw_) = a##S##0; *(uint4*)(Aw_ + 32 * 64) = a##S##1; *(uint4*)(Aw_ + 64 * 64) = a##S##2; *(uint4*)(Aw_ + 96 * 64) = a##S##3; \
        *(uint4*)(Bw_) = b##S##0; *(uint4*)(Bw_ + 32 * 64) = b##S##1; *(uint4*)(Bw_ + 64 * 64) = b##S##2; *(uint4*)(Bw_ + 96 * 64) = b##S##3; }
#define T_COMPUTE(BUF) { const bf16_t* Ab = As + (BUF) * 128 * 64 + (wr * 64 + l15) * 64; const bf16_t* Bb = Bs + (BUF) * 128 * 64 + (wc * 64 + l15) * 64; \
        _Pragma("unroll") for (int ks = 0; ks < 2; ++ks) { const int so = rs0 ^ (ks * 32); bf16x8 af[4], bfr[4]; \
            _Pragma("unroll") for (int i = 0; i < 4; ++i) { af[i] = lds_frag(Ab + i * 16 * 64 + so); bfr[i] = lds_frag(Bb + i * 16 * 64 + so); } \
            _Pragma("unroll") for (int i = 0; i < 4; ++i) _Pragma("unroll") for (int j = 0; j < 4; ++j) acc[i][j] = mfma16(af[i], bfr[j], acc[i][j]); } }
    const int nk = K >> 6;
    const int rs0 = (quad ^ (l15 >> 1)) * 8;
    if (!pre) {
        G_LOAD(0, 0)
        G_LOAD(1, 1)
        L_STORE(0, 0)
        __syncthreads();
    } else {
        G_LOAD(1, 1)
    }
    G_LOAD(0, (nk > 2 ? 2 : nk - 1))
    const bf16_t* Agn = An ? An + (size_t)lr * lda + lc : Ag + (size_t)((nk - 1) << 6);
    const bf16_t* Bgn = An ? Btn + (size_t)lr * ldb + lc : Bg + (size_t)((nk - 1) << 6);
    for (int kt = 0; kt < nk; kt += 2) {
        T_COMPUTE(0)
        L_STORE(1, 1)
        __syncthreads();
        G_LOAD(1, (kt + 3 < nk ? kt + 3 : nk - 1))
        T_COMPUTE(1)
        L_STORE(0, 0)
        __syncthreads();
        G_LOADP(0, (kt + 4 < nk ? Ag + (size_t)((kt + 4) << 6) : Agn), (kt + 4 < nk ? Bg + (size_t)((kt + 4) << 6) : Bgn))
    }
#undef G_LOAD
#undef G_LOADP
#undef L_STORE
#undef T_COMPUTE
    epi(acc, wr, wc, l15, quad);
}

struct EpiInProj {
    const P* p; int e, m0, n0;
    DEVI void operator()(const f32x4 (&acc)[4][4], int wr, int wc, int l15, int quad) const {
        char* ws = p->ws;
        const int rbase = m0 + wr * 64 + quad * 4, cw = n0 + wc * 64;
        if (n0 < 1024) {
            bf16_t* Z = (bf16_t*)(ws + OFF_Z);
#pragma unroll
            for (int mt = 0; mt < 4; ++mt)
#pragma unroll
                for (int nt = 0; nt < 4; ++nt)
#pragma unroll
                    for (int j = 0; j < 4; ++j) Z[(size_t)(rbase + mt * 16 + j) * 1024 + cw + nt * 16 + l15] = f2bf(acc[mt][nt][j]);
        } else if (n0 < 3072) {
            bf16_t* XB = (bf16_t*)(ws + OFF_XBC);
#pragma unroll
            for (int mt = 0; mt < 4; ++mt)
#pragma unroll
                for (int nt = 0; nt < 4; ++nt)
#pragma unroll
                    for (int j = 0; j < 4; ++j) XB[(size_t)(rbase + mt * 16 + j) * 2048 + (cw - 1024) + nt * 16 + l15] = f2bf(acc[mt][nt][j]);
        } else if (n0 < 5120) {
            const bool isq = n0 < 4096;
            const int cc = cw - (isq ? 3072 : 4096);
            const int head = cc >> 7, d128 = cc & 127;
            const bool sample = m0 >= 4096;
            const float* rope = (const float*)(ws + OFF_ROPE);
#pragma unroll
            for (int mt = 0; mt < 4; ++mt)
#pragma unroll
                for (int j = 0; j < 4; ++j) {
                    const int r = rbase + mt * 16 + j;
                    float v0 = acc[mt][0][j], v1 = acc[mt][1][j], v2 = acc[mt][2][j], v3 = acc[mt][3][j];
                    if (!isq && !sample) {
                        const int b = r >> 8, t = r & 255;
                        float* nk = p->out + 8388608 + ((size_t)((b * 2 + e) * 256 + t)) * 1024 + cc;
                        nk[l15] = v0; nk[16 + l15] = v1; nk[32 + l15] = v2; nk[48 + l15] = v3;
                    }
                    if (sample) {
                        const int t = (r - 4096) & 1023, prow = t >> 6, pcol = t & 63;
                        const float cr = rope[(prow * 16 + l15) * 2], sr = rope[(prow * 16 + l15) * 2 + 1];
                        const float ccs = rope[(pcol * 16 + l15) * 2], scs = rope[(pcol * 16 + l15) * 2 + 1];
                        const float a0 = v0 * cr - v1 * sr, b0 = v0 * sr + v1 * cr;
                        const float a1 = v2 * ccs - v3 * scs, b1 = v2 * scs + v3 * ccs;
                        v0 = a0; v1 = b0; v2 = a1; v3 = b1;
                    }
                    bf16_t* dst;
                    if (isq) dst = (bf16_t*)(ws + OFF_Q) + (size_t)r * 1024 + cc;
                    else if (!sample) { const int b = r >> 8, t = r & 255; dst = (bf16_t*)(ws + OFF_KP) + ((size_t)((b * 8 + head) * 256 + t)) * 128 + d128; }
                    else { const int s = (r - 4096) >> 10, t = (r - 4096) & 1023; dst = (bf16_t*)(ws + OFF_KS) + ((size_t)((s * 8 + head) * 1536 + 512 + t)) * 128 + d128; }
                    dst[l15] = f2bf(v0); dst[16 + l15] = f2bf(v1); dst[32 + l15] = f2bf(v2); dst[48 + l15] = f2bf(v3);
                }
        } else if (n0 < 6144) {
            const int cc = cw - 5120, head = cc >> 7, e0 = cc & 127;
            const bool sample = m0 >= 4096;
#pragma unroll
            for (int mt = 0; mt < 4; ++mt) {
                const int r0 = rbase + mt * 16;
                if (!sample) {
                    const int b = r0 >> 8, t = r0 & 255;
#pragma unroll
                    for (int nt = 0; nt < 4; ++nt) {
#pragma unroll
                        for (int j = 0; j < 4; ++j)
                            p->out[16777216 + ((size_t)((b * 2 + e) * 256 + t + j)) * 1024 + cc + nt * 16 + l15] = acc[mt][nt][j];
                        uint2 pk; pk.x = pack2(acc[mt][nt][0], acc[mt][nt][1]); pk.y = pack2(acc[mt][nt][2], acc[mt][nt][3]);
                        *(uint2*)((bf16_t*)(ws + OFF_VTP) + ((size_t)((b * 8 + head) * 128 + e0 + nt * 16 + l15)) * 256 + t) = pk;
                    }
                } else {
                    const int s = (r0 - 4096) >> 10, t = (r0 - 4096) & 1023;
#pragma unroll
                    for (int nt = 0; nt < 4; ++nt) {
                        uint2 pk; pk.x = pack2(acc[mt][nt][0], acc[mt][nt][1]); pk.y = pack2(acc[mt][nt][2], acc[mt][nt][3]);
                        *(uint2*)((bf16_t*)(ws + OFF_VTS) + ((size_t)((s * 8 + head) * 128 + e0 + nt * 16 + l15)) * 1536 + 512 + t) = pk;
                    }
                }
            }
        } else {
            if (wc == 0) {
                float* DR = (float*)(ws + OFF_DTRAW);
#pragma unroll
                for (int mt = 0; mt < 4; ++mt)
#pragma unroll
                    for (int nt = 0; nt < 2; ++nt)
#pragma unroll
                        for (int j = 0; j < 4; ++j) DR[(size_t)(rbase + mt * 16 + j) * 32 + nt * 16 + l15] = acc[mt][nt][j];
            }
        }
    }
};

struct EpiResid {
    float* X; const float* gate; const float* bias; int m0, n0;
    DEVI void operator()(const f32x4 (&acc)[4][4], int wr, int wc, int l15, int quad) const {
        const int rbase = m0 + wr * 64 + quad * 4, cw = n0 + wc * 64;
        const float* gt = gate + (size_t)rowgrp(m0) * 6144;
#pragma unroll
        for (int nt = 0; nt < 4; ++nt) {
            const int c = cw + nt * 16 + l15;
            const float g = gt[c], b = bias ? bias[c] : 0.f;
#pragma unroll
            for (int mt = 0; mt < 4; ++mt)
#pragma unroll
                for (int j = 0; j < 4; ++j) { float* xp = X + (size_t)(rbase + mt * 16 + j) * 1024 + c; *xp = *xp + g * (acc[mt][nt][j] + b); }
        }
    }
};

struct EpiSwiglu {
    bf16_t* HID; int m0, jt;
    DEVI void operator()(const f32x4 (&acc)[4][4], int wr, int wc, int l15, int quad) const {
        const int rbase = m0 + wr * 64 + quad * 4, hc = jt * 64 + wc * 32;
#pragma unroll
        for (int mt = 0; mt < 4; ++mt)
#pragma unroll
            for (int nt = 0; nt < 2; ++nt)
#pragma unroll
                for (int j = 0; j < 4; ++j)
                    HID[(size_t)(rbase + mt * 16 + j) * FH + hc + nt * 16 + l15] = f2bf(siluf(acc[mt][nt][j]) * acc[mt][nt + 2][j]);
    }
};

struct EpiDftC {
    bf16_t* UVt; int L, tbase, g, nn0;
    DEVI void operator()(const f32x4 (&acc)[4][4], int wr, int wc, int l15, int quad) const {
#pragma unroll
        for (int nt = 0; nt < 4; ++nt) {
            const int n = nn0 + wc * 64 + nt * 16 + l15, isv = n >> 8, ch = g * 256 + (n & 255);
            bf16_t* rowp = UVt + (size_t)ch * (2 * L) + isv * L + tbase + wr * 64 + quad * 4;
#pragma unroll
            for (int mt = 0; mt < 4; ++mt) {
                uint2 pk; pk.x = pack2(acc[mt][nt][0], acc[mt][nt][1]); pk.y = pack2(acc[mt][nt][2], acc[mt][nt][3]);
                *(uint2*)(rowp + mt * 16) = pk;
            }
        }
    }
};

struct EpiBf16 {
    bf16_t* O; int ldo, m0, n0;
    DEVI void operator()(const f32x4 (&acc)[4][4], int wr, int wc, int l15, int quad) const {
        const int rbase = m0 + wr * 64 + quad * 4, cw = n0 + wc * 64;
#pragma unroll
        for (int mt = 0; mt < 4; ++mt)
#pragma unroll
            for (int nt = 0; nt < 4; ++nt)
#pragma unroll
                for (int j = 0; j < 4; ++j) O[(size_t)(rbase + mt * 16 + j) * ldo + cw + nt * 16 + l15] = f2bf(acc[mt][nt][j]);
    }
};

DEVI int map_in(int n) { return n < 3072 ? n : (n < 6144 ? n + 32 : (n < 6176 ? n - 3072 : -1)); }
DEVI int map_ffn(int n) { const int j = n >> 7, wc = (n >> 6) & 1, nt = (n >> 4) & 3, c = n & 15; return ((nt & 2) ? FH : 0) + j * 64 + wc * 32 + (nt & 1) * 16 + c; }

DEVI void cvt_item(const float* __restrict__ src, int ldsrc, bf16_t* __restrict__ dst, int K, int n64, int k32, int kind, int lane) {
    const int n = n64 * 64 + (lane & 15) * 4, k = k32 * 32 + (lane >> 4) * 8;
    const int sc = kind == 1 ? map_in(n) : (kind == 2 ? map_ffn(n) : n);
    float4 v[8];
#pragma unroll
    for (int j = 0; j < 8; ++j) v[j] = sc >= 0 ? *(const float4*)(src + (size_t)(k + j) * ldsrc + sc) : make_float4(0.f, 0.f, 0.f, 0.f);
    uint4 o;
    o.x = pack2(v[0].x, v[1].x); o.y = pack2(v[2].x, v[3].x); o.z = pack2(v[4].x, v[5].x); o.w = pack2(v[6].x, v[7].x); *(uint4*)(dst + (size_t)(n + 0) * K + k) = o;
    o.x = pack2(v[0].y, v[1].y); o.y = pack2(v[2].y, v[3].y); o.z = pack2(v[4].y, v[5].y); o.w = pack2(v[6].y, v[7].y); *(uint4*)(dst + (size_t)(n + 1) * K + k) = o;
    o.x = pack2(v[0].z, v[1].z); o.y = pack2(v[2].z, v[3].z); o.z = pack2(v[4].z, v[5].z); o.w = pack2(v[6].z, v[7].z); *(uint4*)(dst + (size_t)(n + 2) * K + k) = o;
    o.x = pack2(v[0].w, v[1].w); o.y = pack2(v[2].w, v[3].w); o.z = pack2(v[4].w, v[5].w); o.w = pack2(v[6].w, v[7].w); *(uint4*)(dst + (size_t)(n + 3) * K + k) = o;
}

DEVI int cvt_layer_count(int l) { return (l & 1) ? 4736 : 8384; }
DEVI void cvt_layer_item(const P& p, int l, int it, int lane) {
    char* ws = p.ws;
    if ((l & 1) == 0) {
        const int e = l >> 1;
        if (it < 3136) { cvt_item(p.w_in_ab + (size_t)e * 1024 * 6176, 6176, (bf16_t*)(ws + OFF_WTIN) + (size_t)e * NIN * 1024, 1024, it >> 5, it & 31, 1, lane); return; }
        it -= 3136;
        if (it < 1024) { cvt_item(p.w_out_ab + (size_t)e * 2048 * 1024, 1024, (bf16_t*)(ws + OFF_WTOUT) + (size_t)e * 1024 * 2048, 2048, it >> 6, it & 63, 0, lane); return; }
        it -= 1024;
    } else {
        const int o = l >> 1;
        if (it < 512) { cvt_item(p.w_four + (size_t)o * 1024 * 1024, 1024, (bf16_t*)(ws + OFF_WTFOUR) + (size_t)o * 1024 * 1024, 1024, it >> 5, it & 31, 0, lane); return; }
        it -= 512;
    }
    if (it < 2816) { cvt_item(p.w_ffn_in + (size_t)l * 1024 * 5632, 5632, (bf16_t*)(ws + OFF_WTFIN) + (size_t)l * 5632 * 1024, 1024, it >> 5, it & 31, 2, lane); return; }
    it -= 2816;
    cvt_item(p.w_ffn_out + (size_t)l * 2816 * 1024, 1024, (bf16_t*)(ws + OFF_WTFOUT) + (size_t)l * 1024 * 2816, 2816, it / 88, it % 88, 0, lane);
}

DEVI void phase_pre(const P& p, char* smem) {
    char* ws = p.ws;
    const int tid = threadIdx.x, lane = tid & 63, wib = tid >> 6;
    const int gw = blockIdx.x * 4 + wib, nw = gridDim.x * 4;
    const int gt = blockIdx.x * 256 + tid, nt = gridDim.x * 256;
    {
        float* sv = (float*)smem;
        float* part = sv + 5 * 1024;
        for (int i = tid; i < 5 * 1024; i += 256) { const int g = i >> 10, k = i & 1023; sv[i] = siluf(g == 0 ? p.c_ctx[k] : p.c[(g - 1) * 1024 + k]); }
        __syncthreads();
        float* MOD = (float*)(ws + OFF_MOD);
        for (int it = blockIdx.x; it < 384; it += gridDim.x) {
            const int l = it / 96, col = (it % 96) * 64 + lane;
            const float* wp = p.w_ada + (size_t)l * 1024 * 6144 + (size_t)(wib * 256) * 6144 + col;
            float a0 = 0.f, a1 = 0.f, a2 = 0.f, a3 = 0.f, a4 = 0.f;
#pragma unroll 8
            for (int k = 0; k < 256; ++k) {
                const float wv = wp[(size_t)k * 6144]; const int kk = wib * 256 + k;
                a0 += sv[kk] * wv; a1 += sv[1024 + kk] * wv; a2 += sv[2048 + kk] * wv; a3 += sv[3072 + kk] * wv; a4 += sv[4096 + kk] * wv;
            }
            part[(wib * 5 + 0) * 64 + lane] = a0; part[(wib * 5 + 1) * 64 + lane] = a1; part[(wib * 5 + 2) * 64 + lane] = a2;
            part[(wib * 5 + 3) * 64 + lane] = a3; part[(wib * 5 + 4) * 64 + lane] = a4;
            __syncthreads();
            for (int i = tid; i < 320; i += 256) {
                const int g = i >> 6, cl = i & 63, cc = (it % 96) * 64 + cl;
                MOD[((size_t)l * 5 + g) * 6144 + cc] = part[(0 * 5 + g) * 64 + cl] + part[(1 * 5 + g) * 64 + cl] + part[(2 * 5 + g) * 64 + cl] + part[(3 * 5 + g) * 64 + cl] + p.b_ada[(size_t)l * 6144 + cc];
            }
            __syncthreads();
        }
    }
    for (int it = gw; it < 8384; it += nw) cvt_layer_item(p, 0, it, lane);
    {
        float4* X4 = (float4*)(ws + OFF_X);
        const float4* a = (const float4*)p.x_prompt; const float4* b = (const float4*)p.x_sample;
        for (int i = gt; i < 1048576; i += nt) { X4[i] = a[i]; X4[1048576 + i] = b[i]; }
    }
    {
        bf16_t* DL = (bf16_t*)(ws + OFF_DL1024);
        for (int i = gt; i < 1024 * 2048; i += nt) {
            const int lp = i >> 11, k = i & 2047, l = k & 1023; const float x = (float)((lp * l) & 1023) * (1.f / 1024.f);
            DL[i] = f2bf((k < 1024 ? __builtin_amdgcn_cosf(x) : -__builtin_amdgcn_sinf(x)) * (1.f / 32.f));
        }
        bf16_t* DS = (bf16_t*)(ws + OFF_DL256);
        for (int i = gt; i < 256 * 512; i += nt) {
            const int lp = i >> 9, k = i & 511, l = k & 255; const float x = (float)((lp * l) & 255) * (1.f / 256.f);
            DS[i] = f2bf((k < 256 ? __builtin_amdgcn_cosf(x) : -__builtin_amdgcn_sinf(x)) * (1.f / 16.f));
        }
        bf16_t* DC = (bf16_t*)(ws + OFF_DC);
        for (int i = gt; i < 512 * 256; i += nt) {
            const int n = i >> 8, k = i & 255; const float x = (float)(((n & 255) * k) & 255) * (1.f / 256.f);
            DC[i] = f2bf((n < 256 ? __builtin_amdgcn_cosf(x) : __builtin_amdgcn_sinf(x)) * (1.f / 16.f));
        }
        float* rope = (float*)(ws + OFF_ROPE);
        for (int i = gt; i < 1024; i += nt) {
            const int pos = i >> 4, fi = i & 15;
            const float freq = exp2f(-(float)fi * (13.287712379549449f / 16.f));
            const float turns = (float)pos * freq * 0.15915494309189535f;
            rope[i * 2] = __builtin_amdgcn_cosf(turns); rope[i * 2 + 1] = __builtin_amdgcn_sinf(turns);
        }
        if (gt < 2) {
            const float* lq = p.lambda_qk + gt * 256; float s1 = 0.f, s2 = 0.f;
            for (int d = 0; d < 64; ++d) { s1 += lq[d] * lq[64 + d]; s2 += lq[128 + d] * lq[192 + d]; }
            const float li = gt == 0 ? 0.2f : 0.8f - 0.6f * 0.5488116360940264f;
            ((float*)(ws + OFF_LAM))[gt] = __expf(s1) - __expf(s2) + li;
        }
    }
}

DEVI void phase_norm(const P& p, int l, int which) {
    char* ws = p.ws;
    const int lane = threadIdx.x & 63, gw = blockIdx.x * 4 + (threadIdx.x >> 6), nw = gridDim.x * 4;
    const float* X = (const float*)(ws + OFF_X);
    const float* gam = which == 0 ? p.norm_mix + l * 1024 : (which == 1 ? p.norm_ffn + l * 1024 : p.norm_final);
    for (int r0 = gw * 4; r0 < T_ALL; r0 += nw * 4) {
        float4 v[4][4]; float ss[4];
#pragma unroll
        for (int q = 0; q < 4; ++q) {
            const float4* xr = (const float4*)(X + (size_t)(r0 + q) * 1024);
#pragma unroll
            for (int i = 0; i < 4; ++i) v[q][i] = xr[lane + i * 64];
        }
#pragma unroll
        for (int q = 0; q < 4; ++q) {
            float s = 0.f;
#pragma unroll
            for (int i = 0; i < 4; ++i) s += v[q][i].x * v[q][i].x + v[q][i].y * v[q][i].y + v[q][i].z * v[q][i].z + v[q][i].w * v[q][i].w;
            ss[q] = s;
        }
#pragma unroll
        for (int o = 32; o > 0; o >>= 1) {
#pragma unroll
            for (int q = 0; q < 4; ++q) ss[q] += __shfl_xor(ss[q], o);
        }
        float rstd[4];
#pragma unroll
        for (int q = 0; q < 4; ++q) rstd[q] = rsqrtf(ss[q] * (1.f / 1024.f) + 1e-6f);
        if (which == 2) {
#pragma unroll
            for (int i = 0; i < 4; ++i) {
                const float4 g = ((const float4*)gam)[lane + i * 64];
#pragma unroll
                for (int q = 0; q < 4; ++q) { float4 y; y.x = v[q][i].x * rstd[q] * g.x; y.y = v[q][i].y * rstd[q] * g.y; y.z = v[q][i].z * rstd[q] * g.z; y.w = v[q][i].w * rstd[q] * g.w;
                    ((float4*)(p.out + (size_t)(r0 + q) * 1024))[lane + i * 64] = y; }
            }
        } else {
            const float* md = (const float*)(ws + OFF_MOD) + ((size_t)l * 5 + rowgrp(r0)) * 6144 + (which ? 3072 : 0);
#pragma unroll
            for (int i = 0; i < 4; ++i) {
                const float4 g = ((const float4*)gam)[lane + i * 64], sh = ((const float4*)md)[lane + i * 64], sc = ((const float4*)(md + 1024))[lane + i * 64];
                const float gx = g.x * (1.f + sc.x), gy = g.y * (1.f + sc.y), gz = g.z * (1.f + sc.z), gw2 = g.w * (1.f + sc.w);
#pragma unroll
                for (int q = 0; q < 4; ++q) {
                    uint2 pk; pk.x = pack2(v[q][i].x * rstd[q] * gx + sh.x, v[q][i].y * rstd[q] * gy + sh.y);
                    pk.y = pack2(v[q][i].z * rstd[q] * gz + sh.z, v[q][i].w * rstd[q] * gw2 + sh.w);
                    ((uint2*)((bf16_t*)(ws + OFF_HBF) + (size_t)(r0 + q) * 1024))[lane + i * 64] = pk;
                }
            }
        }
    }
}

DEVI void phase_ctx(const P& p, int e) {
    char* ws = p.ws;
    const int gt = blockIdx.x * 256 + threadIdx.x, nt = gridDim.x * 256;
    bf16_t* KS = (bf16_t*)(ws + OFF_KS); bf16_t* VTS = (bf16_t*)(ws + OFF_VTS);
    for (int i = gt; i < 4 * 512 * 8 * 16; i += nt) {
        const int c8 = i & 15, h = (i >> 4) & 7, pos = (i >> 7) & 511, s = i >> 16;
        const float* src = p.cache_k + ((size_t)((s * 2 + e) * 512 + pos)) * 1024 + h * 128 + c8 * 8;
        const float4 a = *(const float4*)src, b = *(const float4*)(src + 4);
        uint4 o; o.x = pack2(a.x, a.y); o.y = pack2(a.z, a.w); o.z = pack2(b.x, b.y); o.w = pack2(b.z, b.w);
        *(uint4*)(KS + ((size_t)((s * 8 + h) * 1536 + pos)) * 128 + c8 * 8) = o;
    }
    for (int i = gt; i < 4 * 8 * 64 * 128; i += nt) {
        const int ee = i & 127, p8 = (i >> 7) & 63, h = (i >> 13) & 7, s = i >> 16;
        const float* src = p.cache_v + ((size_t)((s * 2 + e) * 512 + p8 * 8)) * 1024 + h * 128 + ee;
        float v[8];
#pragma unroll
        for (int j = 0; j < 8; ++j) v[j] = src[(size_t)j * 1024];
        uint4 o; o.x = pack2(v[0], v[1]); o.y = pack2(v[2], v[3]); o.z = pack2(v[4], v[5]); o.w = pack2(v[6], v[7]);
        *(uint4*)(VTS + ((size_t)((s * 8 + h) * 128 + ee)) * 1536 + p8 * 8) = o;
    }
}

DEVI void phase_conv(const P& p, int e) {
    char* ws = p.ws;
    const int gt = blockIdx.x * 256 + threadIdx.x, nt = gridDim.x * 256;
    const bf16_t* XB = (const bf16_t*)(ws + OFF_XBC); bf16_t* XC = (bf16_t*)(ws + OFF_XBCC);
    const float* cw = p.conv_w + (size_t)e * 5 * 2048; const float* cb = p.conv_b + (size_t)e * 2048;
    for (int i = gt; i < T_ALL * 256; i += nt) {
        const int c8 = (i & 255) * 8, r = i >> 8;
        int t, L; if (r < 4096) { t = r & 255; L = 256; } else { t = (r - 4096) & 1023; L = 1024; }
        float acc[8];
#pragma unroll
        for (int j = 0; j < 8; ++j) acc[j] = cb[c8 + j];
#pragma unroll
        for (int wq = 0; wq < 5; ++wq) {
            const int tt = t + wq - 2;
            if (tt >= 0 && tt < L) {
                const uint4 u = *(const uint4*)(XB + (size_t)(r + wq - 2) * 2048 + c8);
                const float4 w0 = *(const float4*)(cw + wq * 2048 + c8), w1 = *(const float4*)(cw + wq * 2048 + c8 + 4);
                acc[0] += w0.x * __uint_as_float(u.x << 16); acc[1] += w0.y * __uint_as_float(u.x & 0xffff0000u);
                acc[2] += w0.z * __uint_as_float(u.y << 16); acc[3] += w0.w * __uint_as_float(u.y & 0xffff0000u);
                acc[4] += w1.x * __uint_as_float(u.z << 16); acc[5] += w1.y * __uint_as_float(u.z & 0xffff0000u);
                acc[6] += w1.z * __uint_as_float(u.w << 16); acc[7] += w1.w * __uint_as_float(u.w & 0xffff0000u);
            }
        }
        uint4 o; o.x = pack2(siluf(acc[0]), siluf(acc[1])); o.y = pack2(siluf(acc[2]), siluf(acc[3])); o.z = pack2(siluf(acc[4]), siluf(acc[5])); o.w = pack2(siluf(acc[6]), siluf(acc[7]));
        *(uint4*)(XC + (size_t)r * 2048 + c8) = o;
    }
    const float* DR = (const float*)(ws + OFF_DTRAW); float* DTp = (float*)(ws + OFF_DT);
    for (int i = gt; i < T_ALL * 32; i += nt) {
        const float x = DR[i] + p.dt_bias[e * 32 + (i & 31)];
        DTp[i] = x > 20.f ? x : log1pf(__expf(x));
    }
}

DEVI void attn_item(const P& p, int e, int it, char* smem) {
    char* ws = p.ws;
    const int tid = threadIdx.x, lane = tid & 63, w = tid >> 6, l15 = lane & 15, quad = lane >> 4;
    const int map = w & 1, rg = w >> 1;
    bf16_t* Ks = (bf16_t*)smem;
    bf16_t* Vs = Ks + 64 * 128;
    bf16_t* Ps = Vs + 128 * 64 + w * 32 * 64;
    const float sscale = 0.125f * 1.4426950408889634f;
    int r0, Lk, h; const bf16_t* Kg; const bf16_t* Vg;
    if (it < 512) { const int s = it >> 7, qb = it & 15; h = (it >> 4) & 7; r0 = 4096 + s * 1024 + qb * 64; Lk = 1536;
        Kg = (const bf16_t*)(ws + OFF_KS) + (size_t)(s * 8 + h) * 1536 * 128; Vg = (const bf16_t*)(ws + OFF_VTS) + (size_t)(s * 8 + h) * 128 * 1536; }
    else { const int i2 = it - 512, b = i2 >> 5, qb = i2 & 3; h = (i2 >> 2) & 7; r0 = b * 256 + qb * 64; Lk = 256;
        Kg = (const bf16_t*)(ws + OFF_KP) + (size_t)(b * 8 + h) * 256 * 128; Vg = (const bf16_t*)(ws + OFF_VTP) + (size_t)(b * 8 + h) * 128 * 256; }
    bf16x8 qf[2][2];
    {
        const bf16_t* qp = (const bf16_t*)(ws + OFF_Q) + (size_t)(r0 + rg * 32 + l15) * 1024 + h * 128 + map * 64 + quad * 8;
#pragma unroll
        for (int mt = 0; mt < 2; ++mt)
#pragma unroll
            for (int ks = 0; ks < 2; ++ks) qf[mt][ks] = *(const bf16x8*)(qp + (size_t)mt * 16 * 1024 + ks * 32);
    }
    f32x4 oacc[2][8];
    float mrow[2], lrow[2];
#pragma unroll
    for (int mt = 0; mt < 2; ++mt) {
#pragma unroll
        for (int i = 0; i < 8; ++i) oacc[mt][i] = (f32x4){0.f, 0.f, 0.f, 0.f};
        mrow[mt] = -1e30f; lrow[mt] = 0.f;
    }
    const int krow = tid >> 4, kc = tid & 15, vrow = tid >> 3, vc = tid & 7;
    const bf16_t* kgp = Kg + (size_t)krow * 128 + kc * 8;
    const bf16_t* vgp = Vg + (size_t)vrow * Lk + vc * 8;
    const int kso = krow * 128 + ((kc ^ (krow & 15)) * 8);
    const int vso = vrow * 64 + ((vc ^ ((vrow >> 1) & 7)) * 8);
    uint4 rk0, rk1, rk2, rk3;
#define ATT_LDK(kn) do { const bf16_t* kq_ = kgp + (size_t)(kn) * 64 * 128; \
        rk0 = *(const uint4*)(kq_); rk1 = *(const uint4*)(kq_ + 16 * 128); rk2 = *(const uint4*)(kq_ + 32 * 128); rk3 = *(const uint4*)(kq_ + 48 * 128); } while (0)
#define ATT_LDV(kn) const bf16_t* vq_ = vgp + (kn) * 64; \
        const uint4 rv0 = *(const uint4*)(vq_), rv1 = *(const uint4*)(vq_ + (size_t)32 * Lk), rv2 = *(const uint4*)(vq_ + (size_t)64 * Lk), rv3 = *(const uint4*)(vq_ + (size_t)96 * Lk);
    ATT_LDK(0);
    const int nkt = Lk >> 6;
    const int vsw = (l15 >> 1) & 7;
    for (int kt = 0; kt < nkt; ++kt) {
        __syncthreads();
        *(uint4*)(Ks + kso) = rk0; *(uint4*)(Ks + kso + 16 * 128) = rk1; *(uint4*)(Ks + kso + 32 * 128) = rk2; *(uint4*)(Ks + kso + 48 * 128) = rk3;
        { ATT_LDV(kt); *(uint4*)(Vs + vso) = rv0; *(uint4*)(Vs + vso + 32 * 64) = rv1; *(uint4*)(Vs + vso + 64 * 64) = rv2; *(uint4*)(Vs + vso + 96 * 64) = rv3; }
        __syncthreads();
        const int kn = kt + 1 < nkt ? kt + 1 : kt;
        ATT_LDK(kn);
        f32x4 sc[2][4];
#pragma unroll
        for (int mt = 0; mt < 2; ++mt)
#pragma unroll
            for (int nt = 0; nt < 4; ++nt) sc[mt][nt] = (f32x4){0.f, 0.f, 0.f, 0.f};
#pragma unroll
        for (int ks = 0; ks < 2; ++ks)
#pragma unroll
            for (int nt = 0; nt < 4; ++nt) {
                const bf16x8 kb = lds_frag(Ks + (nt * 16 + l15) * 128 + (((map * 8 + ks * 4 + quad) ^ l15) * 8));
                sc[0][nt] = mfma16(kb, qf[0][ks], sc[0][nt]);
                sc[1][nt] = mfma16(kb, qf[1][ks], sc[1][nt]);
            }
        bf16x8 pf[2][2];
#pragma unroll
        for (int mt = 0; mt < 2; ++mt) {
            float mx = sc[mt][0][0];
#pragma unroll
            for (int nt = 0; nt < 4; ++nt)
#pragma unroll
                for (int j = 0; j < 4; ++j) mx = fmaxf(mx, sc[mt][nt][j]);
            mx *= sscale;
            mx = fmaxf(mx, __shfl_xor(mx, 16)); mx = fmaxf(mx, __shfl_xor(mx, 32));
            const bool need = mx > mrow[mt] + 8.f;
            const float mnew = need ? mx : mrow[mt], alpha = need ? __builtin_amdgcn_exp2f(mrow[mt] - mnew) : 1.f;
            mrow[mt] = mnew;
            float ps = 0.f;
#pragma unroll
            for (int nt = 0; nt < 4; ++nt)
#pragma unroll
                for (int j = 0; j < 4; ++j) { const float pv = __builtin_amdgcn_exp2f(sc[mt][nt][j] * sscale - mnew); sc[mt][nt][j] = pv; ps += pv; }
            lrow[mt] = lrow[mt] * alpha + ps;
#pragma unroll
            for (int g = 0; g < 2; ++g) {
                union { unsigned u[4]; bf16x8 v; } cv;
                cv.u[0] = pack2(sc[mt][2 * g][0], sc[mt][2 * g][1]); cv.u[1] = pack2(sc[mt][2 * g][2], sc[mt][2 * g][3]);
                cv.u[2] = pack2(sc[mt][2 * g + 1][0], sc[mt][2 * g + 1][1]); cv.u[3] = pack2(sc[mt][2 * g + 1][2], sc[mt][2 * g + 1][3]);
                pf[mt][g] = cv.v;
            }
            if (__any(need)) {
#pragma unroll
                for (int i = 0; i < 8; ++i) { oacc[mt][i][0] *= alpha; oacc[mt][i][1] *= alpha; oacc[mt][i][2] *= alpha; oacc[mt][i][3] *= alpha; }
            }
        }
#pragma unroll
        for (int g = 0; g < 2; ++g) {
            const int c0 = g * 4 + (quad >> 1), hf = (quad & 1) * 4;
#pragma unroll
            for (int i = 0; i < 8; ++i) {
                const bf16_t* vr = Vs + (i * 16 + l15) * 64 + hf;
                union { uint2 h[2]; bf16x8 v; } vv;
                vv.h[0] = *(const uint2*)(vr + ((c0 ^ vsw) * 8));
                vv.h[1] = *(const uint2*)(vr + (((c0 + 2) ^ vsw) * 8));
                oacc[0][i] = mfma16(vv.v, pf[0][g], oacc[0][i]);
                oacc[1][i] = mfma16(vv.v, pf[1][g], oacc[1][i]);
            }
        }
    }
    const float lam = ((const float*)(ws + OFF_LAM))[e];
    const float linit = e == 0 ? 0.2f : 0.8f - 0.6f * 0.5488116360940264f;
    float* Ex = (float*)smem + rg * 32 * 128;
    __syncthreads();
    float linv[2];
#pragma unroll
    for (int mt = 0; mt < 2; ++mt) { float l = lrow[mt]; l += __shfl_xor(l, 16); l += __shfl_xor(l, 32); linv[mt] = (map == 1 ? lam : 1.f) / l; }
    if (map == 1) {
#pragma unroll
        for (int mt = 0; mt < 2; ++mt)
#pragma unroll
            for (int i = 0; i < 8; ++i) {
                f32x4 v = oacc[mt][i]; v[0] *= linv[mt]; v[1] *= linv[mt]; v[2] *= linv[mt]; v[3] *= linv[mt];
                *(f32x4*)(Ex + (mt * 16 + l15) * 128 + i * 16 + quad * 4) = v;
            }
    }
    __syncthreads();
    if (map == 0) {
        const float* subln = p.subln + e * 128;
        bf16_t* OC = (bf16_t*)(ws + OFF_OCAT);
#pragma unroll
        for (int mt = 0; mt < 2; ++mt) {
            f32x4 o[8]; float ss = 0.f;
#pragma unroll
            for (int i = 0; i < 8; ++i) {
                const f32x4 x = *(const f32x4*)(Ex + (mt * 16 + l15) * 128 + i * 16 + quad * 4);
#pragma unroll
                for (int j = 0; j < 4; ++j) { o[i][j] = oacc[mt][i][j] * linv[mt] - x[j]; ss += o[i][j] * o[i][j]; }
            }
            ss += __shfl_xor(ss, 16); ss += __shfl_xor(ss, 32);
            const float rstd = rsqrtf(ss * (1.f / 128.f) + 1e-6f) * (1.f - linit);
            bf16_t* op = OC + (size_t)(r0 + rg * 32 + mt * 16 + l15) * 2048 + 1024 + h * 128 + quad * 4;
#pragma unroll
            for (int i = 0; i < 8; ++i) {
                const f32x4 g = *(const f32x4*)(subln + i * 16 + quad * 4);
                uint2 pk; pk.x = pack2(o[i][0] * rstd * g[0], o[i][1] * rstd * g[1]); pk.y = pack2(o[i][2] * rstd * g[2], o[i][3] * rstd * g[3]);
                *(uint2*)(op + i * 16) = pk;
            }
        }
    }
}

typedef short s16x4 __attribute__((ext_vector_type(4)));
DEVI bf16x8 tr_frag(const bf16_t* tile, int stride, int r0, int c0, int l15, int quad) {
    const bf16_t* a = tile + (r0 + quad * 8 + (l15 >> 2)) * stride + c0 + 4 * (l15 & 3);
    const s16x4 lo = __builtin_amdgcn_ds_read_tr16_b64_v4i16((LAS s16x4*)a);
    const s16x4 hi = __builtin_amdgcn_ds_read_tr16_b64_v4i16((LAS s16x4*)(a + 4 * stride));
    bf16x8 r; r[0] = lo[0]; r[1] = lo[1]; r[2] = lo[2]; r[3] = lo[3]; r[4] = hi[0]; r[5] = hi[1]; r[6] = hi[2]; r[7] = hi[3];
    return r;
}
DEVI void ssd_item(const P& p, int e, int it, char* smem) {
    char* ws = p.ws;
    const int tid = threadIdx.x, lane = tid & 63, w = tid >> 6, l15 = lane & 15, quad = lane >> 4;
    bf16_t* Cs = (bf16_t*)smem;
    bf16_t* Bs = Cs + 64 * 136;
    bf16_t* Hs = Bs + 64 * 136;
    bf16_t* Xs = Hs + 64 * 136;
    bf16_t* Ws = Xs + 64 * 72;
    float* facs = (float*)(Ws + 64 * 72);
    float* ftend = facs + 64;
    const bf16_t* XC = (const bf16_t*)(ws + OFF_XBCC);
    const float* DTp = (const float*)(ws + OFF_DT);
    {
        int seq, h, dir, L, rowbase;
        if (it < 128) { const int s = it >> 5; h = (it >> 1) & 15; dir = it & 1; seq = 16 + s; L = 1024; rowbase = 4096 + s * 1024; }
        else { const int i2 = it - 128; seq = i2 >> 5; h = (i2 >> 1) & 15; dir = i2 & 1; L = 256; rowbase = seq * 256; }
        const int g = h >> 2;
        const float a = -__expf(p.a_log[e * 32 + dir * 16 + h]);
        bf16_t* Y = (bf16_t*)(ws + (dir ? OFF_YB : OFF_YF));
        f32x4 hst[8];
        if (seq >= 16) {
            const float* h0 = (dir ? p.st_b : p.st_f) + ((size_t)(((seq - 16) * 2 + e) * 16 + h)) * 64 * 128;
#pragma unroll
            for (int nt = 0; nt < 8; ++nt)
#pragma unroll
                for (int j = 0; j < 4; ++j) hst[nt][j] = h0[(size_t)(16 * w + quad * 4 + j) * 128 + nt * 16 + l15];
        } else {
#pragma unroll
            for (int nt = 0; nt < 8; ++nt) hst[nt] = (f32x4){0.f, 0.f, 0.f, 0.f};
        }
        const int nch = L >> 6;
        for (int c = 0; c < nch; ++c) {
            __syncthreads();
#pragma unroll
            for (int i = 0; i < 4; ++i) {
                const int id = tid + i * 256, row = id >> 4, cc = id & 15;
                const int pos = c * 64 + row, t = dir ? L - 1 - pos : pos;
                const bf16_t* src = XC + (size_t)(rowbase + t) * 2048;
                *(uint4*)(Bs + row * 136 + cc * 8) = *(const uint4*)(src + 1024 + g * 128 + cc * 8);
                *(uint4*)(Cs + row * 136 + cc * 8) = *(const uint4*)(src + 1536 + g * 128 + cc * 8);
            }
#pragma unroll
            for (int i = 0; i < 2; ++i) {
                const int id = tid + i * 256, row = id >> 3, cc = id & 7;
                const int pos = c * 64 + row, t = dir ? L - 1 - pos : pos;
                const uint4 u = *(const uint4*)(XC + (size_t)(rowbase + t) * 2048 + h * 64 + cc * 8);
                const float dtv = DTp[(size_t)(rowbase + t) * 32 + dir * 16 + h];
                uint4 o;
                o.x = pack2(dtv * __uint_as_float(u.x << 16), dtv * __uint_as_float(u.x & 0xffff0000u));
                o.y = pack2(dtv * __uint_as_float(u.y << 16), dtv * __uint_as_float(u.y & 0xffff0000u));
                o.z = pack2(dtv * __uint_as_float(u.z << 16), dtv * __uint_as_float(u.z & 0xffff0000u));
                o.w = pack2(dtv * __uint_as_float(u.w << 16), dtv * __uint_as_float(u.w & 0xffff0000u));
                *(uint4*)(Xs + row * 72 + cc * 8) = o;
            }
            if (w == 0) {
                const int pos = c * 64 + lane, t = dir ? L - 1 - pos : pos;
                float v = a * DTp[(size_t)(rowbase + t) * 32 + dir * 16 + h];
#pragma unroll
                for (int o = 1; o < 64; o <<= 1) { const float tv = __shfl_up(v, o); if (lane >= o) v += tv; }
                facs[lane] = v;
                ftend[lane] = __expf(__shfl(v, 63) - v);
            }
#pragma unroll
            for (int nt = 0; nt < 8; ++nt)
#pragma unroll
                for (int j = 0; j < 4; ++j) Hs[(16 * w + quad * 4 + j) * 136 + nt * 16 + l15] = f2bf(hst[nt][j]);
            __syncthreads();
            f32x4 sacc[4], yacc[4];
#pragma unroll
            for (int nt = 0; nt < 4; ++nt) { sacc[nt] = (f32x4){0.f, 0.f, 0.f, 0.f}; yacc[nt] = (f32x4){0.f, 0.f, 0.f, 0.f}; }
#pragma unroll
            for (int ks = 0; ks < 4; ++ks) {
                const bf16x8 cf = lds_frag(Cs + (16 * w + l15) * 136 + ks * 32 + quad * 8);
#pragma unroll
                for (int nt = 0; nt < 4; ++nt) {
                    sacc[nt] = mfma16(cf, lds_frag(Bs + (nt * 16 + l15) * 136 + ks * 32 + quad * 8), sacc[nt]);
                    yacc[nt] = mfma16(cf, lds_frag(Hs + (nt * 16 + l15) * 136 + ks * 32 + quad * 8), yacc[nt]);
                }
            }
            const float alast = facs[63];
#pragma unroll
            for (int j = 0; j < 4; ++j) {
                const int i = 16 * w + quad * 4 + j; const float ai = facs[i], ei = __expf(ai);
#pragma unroll
                for (int nt = 0; nt < 4; ++nt) {
                    const int jj = nt * 16 + l15;
                    const float wv = jj <= i ? sacc[nt][j] * __expf(fminf(ai - facs[jj], 0.f)) : 0.f;
                    Ws[i * 72 + jj] = f2bf(wv);
                    yacc[nt][j] *= ei;
                }
            }
            asm volatile("s_waitcnt lgkmcnt(0)" ::: "memory");
#pragma unroll
            for (int ks = 0; ks < 2; ++ks) {
                const bf16x8 wf = lds_frag(Ws + (16 * w + l15) * 72 + ks * 32 + quad * 8);
#pragma unroll
                for (int nt = 0; nt < 4; ++nt) yacc[nt] = mfma16(wf, tr_frag(Xs, 72, ks * 32, nt * 16, l15, quad), yacc[nt]);
            }
#pragma unroll
            for (int j = 0; j < 4; ++j) {
                const int i = 16 * w + quad * 4 + j, pos = c * 64 + i, t = dir ? L - 1 - pos : pos;
                bf16_t* yp = Y + (size_t)(rowbase + t) * 1024 + h * 64;
#pragma unroll
                for (int nt = 0; nt < 4; ++nt) yp[nt * 16 + l15] = f2bf(yacc[nt][j]);
            }
            if (seq < 16 || c + 1 < nch) {
                const float dec = __expf(alast);
#pragma unroll
                for (int nt = 0; nt < 8; ++nt) { hst[nt][0] *= dec; hst[nt][1] *= dec; hst[nt][2] *= dec; hst[nt][3] *= dec; }
#pragma unroll
                for (int ks = 0; ks < 2; ++ks) {
                    bf16x8 xa = tr_frag(Xs, 72, ks * 32, 16 * w, l15, quad);
#pragma unroll
                    for (int q = 0; q < 8; ++q) {
                        const int jj = ks * 32 + quad * 8 + q;
                        xa[q] = (short)f2bf(bf2f((bf16_t)xa[q]) * ftend[jj]);
                    }
#pragma unroll
                    for (int nt = 0; nt < 8; ++nt) hst[nt] = mfma16(xa, tr_frag(Bs, 136, ks * 32, nt * 16, l15, quad), hst[nt]);
                }
            }
        }
        if (seq < 16) {
            float* o = p.out + (dir ? 29360128 : 25165824) + ((size_t)((seq * 2 + e) * 16 + h)) * 64 * 128;
#pragma unroll
            for (int nt = 0; nt < 8; ++nt)
#pragma unroll
                for (int j = 0; j < 4; ++j) o[(size_t)(16 * w + quad * 4 + j) * 128 + nt * 16 + l15] = hst[nt][j];
        }
    }
}

DEVI void phase_mixers(const P& p, int e, char* smem) {
    unsigned* qctr = (unsigned*)(p.ws + OFF_BAR) + 3456 + 64 * e;
    volatile int* s_item = (volatile int*)(smem + LDS_BYTES - 16);
#define QUEUE_LOOP(QI, N, CALL) for (;;) { __syncthreads(); if (threadIdx.x == 0) *s_item = (int)atomicAdd(qctr + (QI) * 16, 1u); __syncthreads(); \
        const int it = __builtin_amdgcn_readfirstlane(*s_item); if (it >= (N)) break; CALL; }
    QUEUE_LOOP(0, 640, ssd_item(p, e, it, smem))
    QUEUE_LOOP(1, 1024, attn_item(p, e, it, smem))
    {
        const int lane = threadIdx.x & 63, wib = threadIdx.x >> 6;
        const int la = e == 0 ? 1 : 3, na = 4736, nb = e == 0 ? 8384 : 0;
        QUEUE_LOOP(2, (na + nb + 15) >> 4, {
            for (int q = 0; q < 4; ++q) { const int wi = it * 16 + q * 4 + wib;
                if (wi < na) cvt_layer_item(p, la, wi, lane); else if (wi < na + nb) cvt_layer_item(p, 2, wi - na, lane); } })
    }
}

DEVI void phase_combine(const P& p, int e) {
    char* ws = p.ws;
    const int lane = threadIdx.x & 63, gw = blockIdx.x * 4 + (threadIdx.x >> 6), nw = gridDim.x * 4;
    const bf16_t* YF = (const bf16_t*)(ws + OFF_YF); const bf16_t* YB = (const bf16_t*)(ws + OFF_YB);
    const bf16_t* XC = (const bf16_t*)(ws + OFF_XBCC); const bf16_t* Z = (const bf16_t*)(ws + OFF_Z);
    bf16_t* OC = (bf16_t*)(ws + OFF_OCAT);
    const float* dsk = p.d_skip + e * 16; const float* gn = p.ssd_norm + e * 1024;
    for (int r0 = gw * 2; r0 < T_ALL; r0 += nw * 2) {
        uint4 yf[2][2], yb[2][2], xs[2][2], zz[2][2];
#pragma unroll
        for (int q = 0; q < 2; ++q)
#pragma unroll
            for (int i = 0; i < 2; ++i) {
                const int c = (lane + i * 64) * 8; const size_t r = r0 + q;
                yf[q][i] = *(const uint4*)(YF + r * 1024 + c); yb[q][i] = *(const uint4*)(YB + r * 1024 + c);
                xs[q][i] = *(const uint4*)(XC + r * 2048 + c); zz[q][i] = *(const uint4*)(Z + r * 1024 + c);
            }
        float v[2][16]; float ss[2];
#pragma unroll
        for (int q = 0; q < 2; ++q) {
            float s_ = 0.f;
#pragma unroll
            for (int i = 0; i < 2; ++i) {
                const int c = (lane + i * 64) * 8;
                const float dk = dsk[c >> 6];
                const unsigned yfa[4] = {yf[q][i].x, yf[q][i].y, yf[q][i].z, yf[q][i].w}, yba[4] = {yb[q][i].x, yb[q][i].y, yb[q][i].z, yb[q][i].w};
                const unsigned xsa[4] = {xs[q][i].x, xs[q][i].y, xs[q][i].z, xs[q][i].w}, za[4] = {zz[q][i].x, zz[q][i].y, zz[q][i].z, zz[q][i].w};
#pragma unroll
                for (int k = 0; k < 4; ++k) {
                    const float y0 = __uint_as_float(yfa[k] << 16) + __uint_as_float(yba[k] << 16) + dk * __uint_as_float(xsa[k] << 16);
                    const float y1 = __uint_as_float(yfa[k] & 0xffff0000u) + __uint_as_float(yba[k] & 0xffff0000u) + dk * __uint_as_float(xsa[k] & 0xffff0000u);
                    const float g0 = y0 * siluf(__uint_as_float(za[k] << 16)), g1 = y1 * siluf(__uint_as_float(za[k] & 0xffff0000u));
                    v[q][i * 8 + k * 2] = g0; v[q][i * 8 + k * 2 + 1] = g1; s_ += g0 * g0 + g1 * g1;
                }
            }
            ss[q] = s_;
        }
#pragma unroll
        for (int o = 32; o > 0; o >>= 1) { ss[0] += __shfl_xor(ss[0], o); ss[1] += __shfl_xor(ss[1], o); }
#pragma unroll
        for (int q = 0; q < 2; ++q) {
            const float rstd = rsqrtf(ss[q] * (1.f / 1024.f) + 1e-6f);
#pragma unroll
            for (int i = 0; i < 2; ++i) {
                const int c = (lane + i * 64) * 8;
                const float4 g0 = *(const float4*)(gn + c), g1 = *(const float4*)(gn + c + 4);
                uint4 o; o.x = pack2(v[q][i * 8 + 0] * rstd * g0.x, v[q][i * 8 + 1] * rstd * g0.y); o.y = pack2(v[q][i * 8 + 2] * rstd * g0.z, v[q][i * 8 + 3] * rstd * g0.w);
                o.z = pack2(v[q][i * 8 + 4] * rstd * g1.x, v[q][i * 8 + 5] * rstd * g1.y); o.w = pack2(v[q][i * 8 + 6] * rstd * g1.z, v[q][i * 8 + 7] * rstd * g1.w);
                *(uint4*)(OC + (size_t)(r0 + q) * 2048 + c) = o;
            }
        }
    }
}

DEVI void phase_inproj(const P& p, int e, char* smem) {
    const bf16_t* A = (const bf16_t*)(p.ws + OFF_HBF); const bf16_t* Bt = (const bf16_t*)(p.ws + OFF_WTIN) + (size_t)e * NIN * 1024;
    bool pre = false;
    for (int t = blockIdx.x; t < 64 * 49; t += gridDim.x) {
        const int m0 = (t & 63) * 128, n0 = (t >> 6) * 128, tn = t + gridDim.x; const bool nx = tn < 64 * 49;
        EpiInProj ep{&p, e, m0, n0};
        gemm_tile(A + (size_t)m0 * 1024, 1024, Bt + (size_t)n0 * 1024, 1024, 1024, smem, ep,
                  nx ? A + (size_t)(tn & 63) * 128 * 1024 : nullptr, nx ? Bt + (size_t)(tn >> 6) * 128 * 1024 : nullptr, pre);
        pre = nx;
    }
}
DEVI void phase_resid_gemm(const P& p, const bf16_t* A, int lda, const bf16_t* Bt, int K, const float* gate, const float* bias, char* smem) {
    float* X = (float*)(p.ws + OFF_X);
    for (int t = blockIdx.x; t < 64 * 8; t += gridDim.x) {
        const int m0 = (t & 63) * 128, n0 = (t >> 6) * 128;
        EpiResid ep{X, gate, bias, m0, n0};
        gemm_tile(A + (size_t)m0 * lda, lda, Bt + (size_t)n0 * K, K, K, smem, ep);
    }
}
DEVI void phase_ffn_in(const P& p, int l, char* smem) {
    const bf16_t* A = (const bf16_t*)(p.ws + OFF_HBF); const bf16_t* Bt = (const bf16_t*)(p.ws + OFF_WTFIN) + (size_t)l * 5632 * 1024;
    bool pre = false;
    for (int t = blockIdx.x; t < 64 * 44; t += gridDim.x) {
        const int m0 = (t & 63) * 128, jt = t >> 6, tn = t + gridDim.x; const bool nx = tn < 64 * 44;
        EpiSwiglu ep{(bf16_t*)(p.ws + OFF_HID), m0, jt};
        gemm_tile(A + (size_t)m0 * 1024, 1024, Bt + (size_t)jt * 128 * 1024, 1024, 1024, smem, ep,
                  nx ? A + (size_t)(tn & 63) * 128 * 1024 : nullptr, nx ? Bt + (size_t)(tn >> 6) * 128 * 1024 : nullptr, pre);
        pre = nx;
    }
}
DEVI void phase_dftc(const P& p, char* smem) {
    const bf16_t* A = (const bf16_t*)(p.ws + OFF_HBF); const bf16_t* Bt = (const bf16_t*)(p.ws + OFF_DC);
    for (int t = blockIdx.x; t < 64 * 16; t += gridDim.x) {
        const int m0 = (t & 63) * 128, gn = t >> 6, g = gn >> 2, nn0 = (gn & 3) * 128;
        EpiDftC ep;
        if (m0 < 4096) { ep.UVt = (bf16_t*)(p.ws + OFF_UVTP) + (size_t)(m0 >> 8) * 1024 * 512; ep.L = 256; ep.tbase = m0 & 255; }
        else { ep.UVt = (bf16_t*)(p.ws + OFF_UVTS) + (size_t)((m0 - 4096) >> 10) * 1024 * 2048; ep.L = 1024; ep.tbase = (m0 - 4096) & 1023; }
        ep.g = g; ep.nn0 = nn0;
        gemm_tile(A + (size_t)m0 * 1024 + g * 256, 1024, Bt + (size_t)nn0 * 256, 256, 256, smem, ep);
    }
}
DEVI void phase_dftl(const P& p, char* smem) {
    bf16_t* F = (bf16_t*)(p.ws + OFF_F);
    for (int t = blockIdx.x; t < 512; t += gridDim.x) {
        const bf16_t* A; const bf16_t* Bt; int K2, row0, nt;
        if (t < 256) {
            const int s = t >> 6, mt = (t >> 3) & 7; nt = t & 7; K2 = 2048; row0 = 4096 + s * 1024 + mt * 128;
            A = (const bf16_t*)(p.ws + OFF_DL1024) + (size_t)mt * 128 * 2048; Bt = (const bf16_t*)(p.ws + OFF_UVTS) + ((size_t)s * 1024 + nt * 128) * 2048;
        } else {
            const int i2 = t - 256, b = i2 >> 4, mt = (i2 >> 3) & 1; nt = i2 & 7; K2 = 512; row0 = b * 256 + mt * 128;
            A = (const bf16_t*)(p.ws + OFF_DL256) + (size_t)mt * 128 * 512; Bt = (const bf16_t*)(p.ws + OFF_UVTP) + ((size_t)b * 1024 + nt * 128) * 512;
        }
        EpiBf16 ep{F, 1024, row0, nt * 128};
        gemm_tile(A, K2, Bt, K2, K2, smem, ep);
    }
}

#define XB_TMO      128
#define XB_XCNT(j)  (256  + 64 * (j))
#define XB_XSUB(j)  (1280 + 64 * (j))
#define XB_XGEN(j)  (2304 + 64 * (j))
#define XB_TOP      3328
#define XB_TOPGEN   3392
#define XCD_BAR_WORDS 3456
#define XB_SPIN_CAP (1u << 22)
DEVI unsigned xb_ld(unsigned* p)              { return __hip_atomic_load(p, __ATOMIC_RELAXED, __HIP_MEMORY_SCOPE_AGENT); }
DEVI unsigned xb_add(unsigned* p, unsigned v) { return __hip_atomic_fetch_add(p, v, __ATOMIC_RELAXED, __HIP_MEMORY_SCOPE_AGENT); }
DEVI unsigned xb_xcc_id() { return (unsigned)__builtin_amdgcn_s_getreg((3 << 11) | 20) & 0xFu; }
#define XB_SPIN(cond, bar) do { unsigned _sp = 0; while (cond) { __builtin_amdgcn_s_sleep(1); \
    if ((++_sp & 255u) == 0u) { if (xb_ld(&(bar)[XB_TMO])) break; if (_sp > XB_SPIN_CAP) { atomicAdd(&(bar)[XB_TMO], 1u); break; } } } } while (0)
struct XcdBarrier { unsigned* bar; unsigned x; volatile LAS unsigned* st; };
DEVI XcdBarrier xcd_barrier_post(unsigned* bar, volatile LAS unsigned* st) {
    XcdBarrier b; b.bar = bar; b.x = xb_xcc_id(); b.st = st;
    if (threadIdx.x == 0) (void)xb_add(&bar[XB_XCNT(b.x)], 1u);
    return b;
}
DEVI void xcd_barrier_complete(unsigned* bar, unsigned x, unsigned& nloc, unsigned& nx) {
    const unsigned G = gridDim.x * gridDim.y * gridDim.z;
    unsigned sum, cnt, mine, sp = 0u;
    for (;;) {
        sum = 0u; cnt = 0u; mine = 0u;
#pragma unroll
        for (unsigned j = 0; j < 16; ++j) { const unsigned c = xb_ld(&bar[XB_XCNT(j)]); sum += c; cnt += (c > 0u) ? 1u : 0u; mine = (j == x) ? c : mine; }
        if (sum == G) break;
        __builtin_amdgcn_s_sleep(1);
        if ((++sp & 255u) == 0u) { if (xb_ld(&bar[XB_TMO])) break; if (sp > XB_SPIN_CAP) { atomicAdd(&bar[XB_TMO], 1u); break; } }
    }
    nloc = mine > 0u ? mine : 1u; nx = cnt > 0u ? cnt : 1u;
}
DEVI void xcd_barrier(const XcdBarrier& b) {
    asm volatile("s_waitcnt vmcnt(0)" ::: "memory");
    __syncthreads();
    if (threadIdx.x == 0) {
        unsigned* bar = b.bar;
        __builtin_amdgcn_s_waitcnt(0);
        unsigned nloc = b.st[0], nx = b.st[1];
        if (nloc == 0u) { xcd_barrier_complete(bar, b.x, nloc, nx); b.st[0] = nloc; b.st[1] = nx; }
        const unsigned old = xb_add(&bar[XB_XSUB(b.x)], 1u);
        const unsigned gen = old / nloc;
        if (old + 1u == (gen + 1u) * nloc) {
            __builtin_amdgcn_fence(__ATOMIC_RELEASE, "agent");
            asm volatile("s_waitcnt vmcnt(0)" ::: "memory");
            const unsigned og = xb_add(&bar[XB_TOP], 1u);
            const unsigned tg = og / nx;
            if (og + 1u == (tg + 1u) * nx) xb_add(&bar[XB_TOPGEN], 1u);
            else XB_SPIN(xb_ld(&bar[XB_TOPGEN]) == tg, bar);
            __builtin_amdgcn_fence(__ATOMIC_ACQUIRE, "agent");
            xb_add(&bar[XB_XGEN(b.x)], 1u);
            asm volatile("s_waitcnt vmcnt(0)" ::: "memory");
        } else {
            XB_SPIN(xb_ld(&bar[XB_XGEN(b.x)]) == gen, bar);
            __builtin_amdgcn_fence(__ATOMIC_ACQUIRE, "agent");
            asm volatile("s_waitcnt vmcnt(0)" ::: "memory");
        }
    }
    __syncthreads();
}

DEVI void run_phase(const P& p, int ph, char* smem) {
    if (ph == 0) { phase_pre(p, smem); return; }
    if (ph == 33) { phase_norm(p, 0, 2); return; }
    int q = ph - 1, l;
    if (q < 9) l = 0; else if (q < 16) { l = 1; q -= 9; } else if (q < 25) { l = 2; q -= 16; } else { l = 3; q -= 25; }
    const float* MODl = (const float*)(p.ws + OFF_MOD) + (size_t)l * 5 * 6144;
    int f;
    if ((l & 1) == 0) {
        const int e = l >> 1;
        f = q - 6;
        switch (q) {
            case 0: phase_norm(p, l, 0); phase_ctx(p, e); break;
            case 1: phase_inproj(p, e, smem); break;
            case 2: phase_conv(p, e); break;
            case 3: phase_mixers(p, e, smem); break;
            case 4: phase_combine(p, e); break;
            case 5: phase_resid_gemm(p, (const bf16_t*)(p.ws + OFF_OCAT), 2048, (const bf16_t*)(p.ws + OFF_WTOUT) + (size_t)e * 1024 * 2048, 2048, MODl + 2048, nullptr, smem); break;
            default: break;
        }
    } else {
        const int o = l >> 1;
        f = q - 4;
        switch (q) {
            case 0: phase_norm(p, l, 0); break;
            case 1: phase_dftc(p, smem); break;
            case 2: phase_dftl(p, smem); break;
            case 3: phase_resid_gemm(p, (const bf16_t*)(p.ws + OFF_F), 1024, (const bf16_t*)(p.ws + OFF_WTFOUR) + (size_t)o * 1024 * 1024, 1024, MODl + 2048, p.b_four + o * 1024, smem); break;
            default: break;
        }
    }
    if (f == 0) phase_norm(p, l, 1);
    else if (f == 1) phase_ffn_in(p, l, smem);
    else if (f == 2) phase_resid_gemm(p, (const bf16_t*)(p.ws + OFF_HID), FH, (const bf16_t*)(p.ws + OFF_WTFOUT) + (size_t)l * 1024 * 2816, FH, MODl + 5120, nullptr, smem);
}

typedef const __attribute__((address_space(4))) P* KP;
DEVI const P& kargs() { KP k = (KP)__builtin_amdgcn_kernarg_segment_ptr(); asm volatile("" : "+s"(k)); return *(const P*)k; }

#ifndef PROBE_CLASS
#define PROBE_CLASS -1
#endif
constexpr int phase_class(int ph) {
    if (ph == 0) return 0;
    if (ph == 33) return 1;
    int q = ph - 1; bool even = true;
    if (q < 9) {} else if (q < 16) { even = false; q -= 9; } else if (q < 25) { q -= 16; } else { even = false; q -= 25; }
    if (even) { constexpr int t[9] = {1, 2, 3, 4, 5, 6, 1, 7, 6}; return t[q]; }
    constexpr int t[7] = {1, 8, 9, 6, 1, 7, 6}; return t[q];
}
template <bool COOP, int PH> struct Seq {
    static DEVI void run(const XcdBarrier& xb, char* smem, int lo, int hi) {
        if (PH >= lo && PH <= hi) {
            if (phase_class(PH) == PROBE_CLASS) run_phase(kargs(), PH, smem);
            run_phase(kargs(), PH, smem);
            if (COOP) { if (PH < hi) { xcd_barrier(xb); if (PROBE_CLASS == 100) { xcd_barrier(xb); xcd_barrier(xb); } } }
        }
        Seq<COOP, PH + 1>::run(xb, smem, lo, hi);
    }
};
template <bool COOP> struct Seq<COOP, NPHASE> { static DEVI void run(const XcdBarrier&, char*, int, int) {} };

template <bool COOP>
__global__ void __launch_bounds__(256, 2) mega(P p, int ph_lo, int ph_hi) {
    __shared__ __attribute__((aligned(16))) char smem[LDS_BYTES];
    __shared__ uint4 xb_words;
    XcdBarrier xb{};
    if (COOP) {
        if (threadIdx.x == 0) xb_words = make_uint4(0u, 0u, 0u, 0u);
        __syncthreads();
        xb = xcd_barrier_post((unsigned*)(kargs().ws + OFF_BAR), (volatile LAS unsigned*)&xb_words);
        if (ph_lo < 0) cg::this_grid().sync();
    }
    Seq<COOP, 0>::run(xb, smem, ph_lo, ph_hi);
}

extern "C" void kernel_launch(void* const* d_in, const int* in_sizes, int n_in, void* d_out, int out_size, void* d_ws, size_t ws_size, hipStream_t stream) {
    P p{};
    const float** pp = (const float**)&p;
    for (int i = 0; i < 27; ++i) pp[i] = (const float*)d_in[i];
    p.out = (float*)d_out; p.ws = (char*)d_ws;
    if (ws_size < WS_END) { fprintf(stderr, "workspace too small: %zu < %zu\n", ws_size, (size_t)WS_END); return; }
    static int grid_blocks = 0;
    if (!grid_blocks) {
        int dev = 0, cus = 0, per_cu = 0;
        hipGetDevice(&dev);
        hipDeviceGetAttribute(&cus, hipDeviceAttributeMultiprocessorCount, dev);
        hipOccupancyMaxActiveBlocksPerMultiprocessor(&per_cu, mega<true>, 256, 0);
        if (per_cu > 2) per_cu = 2;
        if (per_cu < 1) per_cu = 1;
        grid_blocks = cus * per_cu;
    }
    hipMemsetAsync((char*)d_ws + OFF_BAR, 0, 16384, stream);
    int lo = 0, hi = NPHASE - 1;
    void* args[] = {&p, &lo, &hi};
    hipError_t err = hipLaunchCooperativeKernel((void*)mega<true>, dim3(grid_blocks), dim3(256), args, 0, stream);
    if (err != hipSuccess) fprintf(stderr, "cooperative launch failed: %s (grid %d)\n", hipGetErrorString(err), grid_blocks);

}
```

```cpp
#include <hip/hip_runtime.h>
#include <hip/hip_cooperative_groups.h>
#include <cstdio>
namespace cg = cooperative_groups;

#ifndef USE_COOP
#define USE_COOP 1
#endif

typedef unsigned short bf16_t;
typedef short bf16x8 __attribute__((ext_vector_type(8)));
typedef float f32x4 __attribute__((ext_vector_type(4)));
#define DEVI __device__ __forceinline__
#define LAS __attribute__((address_space(3)))

constexpr int T_ALL = 8192;
constexpr int D = 1024;
constexpr int NIN = 6272;
constexpr int FH = 2816;
constexpr int LDS_BYTES = 73728;
constexpr int NPHASE = 34;

constexpr size_t OFF_WTIN   = 0;
constexpr size_t OFF_WTOUT  = OFF_WTIN   + 2ull * NIN * 1024 * 2;
constexpr size_t OFF_WTFOUR = OFF_WTOUT  + 2ull * 1024 * 2048 * 2;
constexpr size_t OFF_WTFIN  = OFF_WTFOUR + 2ull * 1024 * 1024 * 2;
constexpr size_t OFF_WTFOUT = OFF_WTFIN  + 4ull * 5632 * 1024 * 2;
constexpr size_t OFF_DL1024 = OFF_WTFOUT + 4ull * 1024 * 2816 * 2;
constexpr size_t OFF_DL256  = OFF_DL1024 + 1024ull * 2048 * 2;
constexpr size_t OFF_DC     = OFF_DL256  + 256ull * 512 * 2;
constexpr size_t OFF_ROPE   = OFF_DC     + 512ull * 256 * 2;
constexpr size_t OFF_MOD    = OFF_ROPE   + 64 * 16 * 2 * 4;
constexpr size_t OFF_LAM    = OFF_MOD    + 4ull * 5 * 6144 * 4;
constexpr size_t OFF_X      = OFF_LAM    + 256;
constexpr size_t OFF_HBF    = OFF_X      + 8192ull * 1024 * 4;
constexpr size_t OFF_Z      = OFF_HBF    + 8192ull * 1024 * 2;
constexpr size_t OFF_XBC    = OFF_Z      + 8192ull * 1024 * 2;
constexpr size_t OFF_Q      = OFF_XBC    + 8192ull * 2048 * 2;
constexpr size_t OFF_KP     = OFF_Q      + 8192ull * 1024 * 2;
constexpr size_t OFF_KS     = OFF_KP     + 16ull * 8 * 256 * 128 * 2;
constexpr size_t OFF_VTP    = OFF_KS     + 4ull * 8 * 1536 * 128 * 2;
constexpr size_t OFF_VTS    = OFF_VTP    + 16ull * 8 * 128 * 256 * 2;
constexpr size_t OFF_XBCC   = OFF_VTS    + 4ull * 8 * 128 * 1536 * 2;
constexpr size_t OFF_DTRAW  = OFF_XBCC   + 8192ull * 2048 * 2;
constexpr size_t OFF_DT     = OFF_DTRAW  + 8192ull * 32 * 4;
constexpr size_t OFF_OCAT   = OFF_DT     + 8192ull * 32 * 4;
constexpr size_t OFF_BAR    = OFF_OCAT   + 8192ull * 2048 * 2;
constexpr size_t WS_END     = OFF_BAR    + 16384;
constexpr size_t OFF_HID  = OFF_Z;
constexpr size_t OFF_F    = OFF_Z;
constexpr size_t OFF_UVTP = OFF_XBC;
constexpr size_t OFF_UVTS = OFF_XBC + 16ull * 1024 * 512 * 2;
constexpr size_t OFF_YF   = OFF_XBC;
constexpr size_t OFF_YB   = OFF_XBC + 8192ull * 1024 * 2;

struct P {
    const float *x_prompt, *x_sample, *cache_k, *cache_v, *st_f, *st_b, *c, *c_ctx, *w_ada, *b_ada, *norm_mix, *norm_ffn,
        *w_in_ab, *conv_w, *conv_b, *dt_bias, *a_log, *d_skip, *ssd_norm, *lambda_qk, *subln, *w_out_ab, *w_four, *b_four,
        *w_ffn_in, *w_ffn_out, *norm_final;
    float* out;
    char* ws;
};

typedef __bf16 bf16v2_t __attribute__((ext_vector_type(2)));
typedef float f32v2_t __attribute__((ext_vector_type(2)));
DEVI unsigned pack2(float a, float b) { f32v2_t v = {a, b}; bf16v2_t r = __builtin_convertvector(v, bf16v2_t); return __builtin_bit_cast(unsigned, r); }
DEVI bf16_t f2bf(float f) { return (bf16_t)(pack2(f, f) & 0xffffu); }
DEVI float bf2f(bf16_t h) { return __uint_as_float(((unsigned)h) << 16); }
DEVI float siluf(float x) { return x * __builtin_amdgcn_rcpf(1.f + __expf(-x)); }
DEVI int rowgrp(int r) { return r < 4096 ? 0 : 1 + ((r - 4096) >> 10); }
DEVI float wave_sum(float v) {
#pragma unroll
    for (int o = 32; o > 0; o >>= 1) v += __shfl_xor(v, o);
    return v;
}
template <int CTRL> DEVI float dpp_f(float v) { return __int_as_float(__builtin_amdgcn_update_dpp(0, __float_as_int(v), CTRL, 0xf, 0xf, true)); }
DEVI float q16_sum(float v) {
#pragma unroll
    for (int o = 8; o > 0; o >>= 1) v += __shfl_xor(v, o);
    return v;
}
DEVI float q16_max(float v) {
#pragma unroll
    for (int o = 8; o > 0; o >>= 1) v = fmaxf(v, __shfl_xor(v, o));
    return v;
}
DEVI f32x4 mfma16(bf16x8 a, bf16x8 b, f32x4 c) { return __builtin_amdgcn_mfma_f32_16x16x32_bf16(a, b, c, 0, 0, 0); }
DEVI bf16x8 lds_frag(const bf16_t* p) { return *(const bf16x8*)p; }

template <class Epi>
DEVI void gemm_tile(const bf16_t* __restrict__ A, int lda, const bf16_t* __restrict__ Bt, int ldb, int K, char* smem, const Epi& epi,
                    const bf16_t* An = nullptr, const bf16_t* Btn = nullptr, bool pre = false) {
    const int tid = threadIdx.x, lane = tid & 63, w = tid >> 6, wr = w >> 1, wc = w & 1, l15 = lane & 15, quad = lane >> 4;
    bf16_t* As = (bf16_t*)smem;
    bf16_t* Bs = As + 2 * 128 * 64;
    f32x4 acc[4][4];
#pragma unroll
    for (int i = 0; i < 4; ++i)
#pragma unroll
        for (int j = 0; j < 4; ++j) acc[i][j] = (f32x4){0.f, 0.f, 0.f, 0.f};
    const int lr = tid >> 3, lc = (tid & 7) * 8;
    const int wofs = lr * 64 + (((tid & 7) ^ ((lr >> 1) & 7)) * 8);
    const bf16_t* Ag = A + (size_t)lr * lda + lc;
    const bf16_t* Bg = Bt + (size_t)lr * ldb + lc;
    uint4 a00, a01, a02, a03, b00, b01, b02, b03, a10, a11, a12, a13, b10, b11, b12, b13;
#define G_LOADP(S, AP, BP) { const bf16_t* ap_ = (AP); const bf16_t* bp_ = (BP); \
        a##S##0 = *(const uint4*)(ap_); a##S##1 = *(const uint4*)(ap_ + (size_t)32 * lda); a##S##2 = *(const uint4*)(ap_ + (size_t)64 * lda); a##S##3 = *(const uint4*)(ap_ + (size_t)96 * lda); \
        b##S##0 = *(const uint4*)(bp_); b##S##1 = *(const uint4*)(bp_ + (size_t)32 * ldb); b##S##2 = *(const uint4*)(bp_ + (size_t)64 * ldb); b##S##3 = *(const uint4*)(bp_ + (size_t)96 * ldb); }
#define G_LOAD(S, KT) { const size_t k0_ = (size_t)((KT) << 6); \
        a##S##0 = *(const uint4*)(Ag + k0_); a##S##1 = *(const uint4*)(Ag + (size_t)32 * lda + k0_); a##S##2 = *(const uint4*)(Ag + (size_t)64 * lda + k0_); a##S##3 = *(const uint4*)(Ag + (size_t)96 * lda + k0_); \
        b##S##0 = *(const uint4*)(Bg + k0_); b##S##1 = *(const uint4*)(Bg + (size_t)32 * ldb + k0_); b##S##2 = *(const uint4*)(Bg + (size_t)64 * ldb + k0_); b##S##3 = *(const uint4*)(Bg + (size_t)96 * ldb + k0_); }
#define L_STORE(S, BUF) { bf16_t* Aw_ = As + (BUF) * 128 * 64 + wofs; bf16_t* Bw_ = Bs + (BUF) * 128 * 64 + wofs; \
        *(uint4*)(Aw_) = a##S##0; *(uint4*)(Aw_ + 32 * 64) = a##S##1; *(uint4*)(Aw_ + 64 * 64) = a##S##2; *(uint4*)(Aw_ + 96 * 64) = a##S##3; \
        *(uint4*)(Bw_) = b##S##0; *(uint4*)(Bw_ + 32 * 64) = b##S##1; *(uint4*)(Bw_ + 64 * 64) = b##S##2; *(uint4*)(Bw_ + 96 * 64) = b##S##3; }
#define T_COMPUTE(BUF) { const bf16_t* Ab = As + (BUF) * 128 * 64 + (wr * 64 + l15) * 64; const bf16_t* Bb = Bs + (BUF) * 128 * 64 + (wc * 64 + l15) * 64; \
        _Pragma("unroll") for (int ks = 0; ks < 2; ++ks) { const int so = rs0 ^ (ks * 32); bf16x8 af[4], bfr[4]; \
            _Pragma("unroll") for (int i = 0; i < 4; ++i) { af[i] = lds_frag(Ab + i * 16 * 64 + so); bfr[i] = lds_frag(Bb + i * 16 * 64 + so); } \
            _Pragma("unroll") for (int i = 0; i < 4; ++i) _Pragma("unroll") for (int j = 0; j < 4; ++j) acc[i][j] = mfma16(af[i], bfr[j], acc[i][j]); } }
    const int nk = K >> 6;
    const int rs0 = (quad ^ (l15 >> 1)) * 8;
    if (!pre) {
        G_LOAD(0, 0)
        G_LOAD(1, 1)
        L_STORE(0, 0)
        __syncthreads();
    } else {
        G_LOAD(1, 1)
    }
    G_LOAD(0, (nk > 2 ? 2 : nk - 1))
    const bf16_t* Agn = An ? An + (size_t)lr * lda + lc : Ag + (size_t)((nk - 1) << 6);
    const bf16_t* Bgn = An ? Btn + (size_t)lr * ldb + lc : Bg + (size_t)((nk - 1) << 6);
    for (int kt = 0; kt < nk; kt += 2) {
        T_COMPUTE(0)
        L_STORE(1, 1)
        __syncthreads();
        G_LOAD(1, (kt + 3 < nk ? kt + 3 : nk - 1))
        T_COMPUTE(1)
        L_STORE(0, 0)
        __syncthreads();
        G_LOADP(0, (kt + 4 < nk ? Ag + (size_t)((kt + 4) << 6) : Agn), (kt + 4 < nk ? Bg + (size_t)((kt + 4) << 6) : Bgn))
    }
#undef G_LOAD
#undef G_LOADP
#undef L_STORE
#undef T_COMPUTE
    epi(acc, wr, wc, l15, quad);
}

struct EpiInProj {
    const P* p; int e, m0, n0;
    DEVI void operator()(const f32x4 (&acc)[4][4], int wr, int wc, int l15, int quad) const {
        char* ws = p->ws;
        const int rbase = m0 + wr * 64 + quad * 4, cw = n0 + wc * 64;
        if (n0 < 1024) {
            bf16_t* Z = (bf16_t*)(ws + OFF_Z);
#pragma unroll
            for (int mt = 0; mt < 4; ++mt)
#pragma unroll
                for (int nt = 0; nt < 4; ++nt)
#pragma unroll
                    for (int j = 0; j < 4; ++j) Z[(size_t)(rbase + mt * 16 + j) * 1024 + cw + nt * 16 + l15] = f2bf(acc[mt][nt][j]);
        } else if (n0 < 3072) {
            bf16_t* XB = (bf16_t*)(ws + OFF_XBC);
#pragma unroll
            for (int mt = 0; mt < 4; ++mt)
#pragma unroll
                for (int nt = 0; nt < 4; ++nt)
#pragma unroll
                    for (int j = 0; j < 4; ++j) XB[(size_t)(rbase + mt * 16 + j) * 2048 + (cw - 1024) + nt * 16 + l15] = f2bf(acc[mt][nt][j]);
        } else if (n0 < 5120) {
            const bool isq = n0 < 4096;
            const int cc = cw - (isq ? 3072 : 4096);
            const int head = cc >> 7, d128 = cc & 127;
            const bool sample = m0 >= 4096;
            const float* rope = (const float*)(ws + OFF_ROPE);
#pragma unroll
            for (int mt = 0; mt < 4; ++mt)
#pragma unroll
                for (int j = 0; j < 4; ++j) {
                    const int r = rbase + mt * 16 + j;
                    float v0 = acc[mt][0][j], v1 = acc[mt][1][j], v2 = acc[mt][2][j], v3 = acc[mt][3][j];
                    if (!isq && !sample) {
                        const int b = r >> 8, t = r & 255;
                        float* nk = p->out + 8388608 + ((size_t)((b * 2 + e) * 256 + t)) * 1024 + cc;
                        nk[l15] = v0; nk[16 + l15] = v1; nk[32 + l15] = v2; nk[48 + l15] = v3;
                    }
                    if (sample) {
                        const int t = (r - 4096) & 1023, prow = t >> 6, pcol = t & 63;
                        const float cr = rope[(prow * 16 + l15) * 2], sr = rope[(prow * 16 + l15) * 2 + 1];
                        const float ccs = rope[(pcol * 16 + l15) * 2], scs = rope[(pcol * 16 + l15) * 2 + 1];
                        const float a0 = v0 * cr - v1 * sr, b0 = v0 * sr + v1 * cr;
                        const float a1 = v2 * ccs - v3 * scs, b1 = v2 * scs + v3 * ccs;
                        v0 = a0; v1 = b0; v2 = a1; v3 = b1;
                    }
                    bf16_t* dst;
                    if (isq) dst = (bf16_t*)(ws + OFF_Q) + (size_t)r * 1024 + cc;
                    else if (!sample) { const int b = r >> 8, t = r & 255; dst = (bf16_t*)(ws + OFF_KP) + ((size_t)((b * 8 + head) * 256 + t)) * 128 + d128; }
                    else { const int s = (r - 4096) >> 10, t = (r - 4096) & 1023; dst = (bf16_t*)(ws + OFF_KS) + ((size_t)((s * 8 + head) * 1536 + 512 + t)) * 128 + d128; }
                    dst[l15] = f2bf(v0); dst[16 + l15] = f2bf(v1); dst[32 + l15] = f2bf(v2); dst[48 + l15] = f2bf(v3);
                }
        } else if (n0 < 6144) {
            const int cc = cw - 5120, head = cc >> 7, e0 = cc & 127;
            const bool sample = m0 >= 4096;
#pragma unroll
            for (int mt = 0; mt < 4; ++mt) {
                const int r0 = rbase + mt * 16;
                if (!sample) {
                    const int b = r0 >> 8, t = r0 & 255;
#pragma unroll
                    for (int nt = 0; nt < 4; ++nt) {
#pragma unroll
                        for (int j = 0; j < 4; ++j)
                            p->out[16777216 + ((size_t)((b * 2 + e) * 256 + t + j)) * 1024 + cc + nt * 16 + l15] = acc[mt][nt][j];
                        uint2 pk; pk.x = pack2(acc[mt][nt][0], acc[mt][nt][1]); pk.y = pack2(acc[mt][nt][2], acc[mt][nt][3]);
                        *(uint2*)((bf16_t*)(ws + OFF_VTP) + ((size_t)((b * 8 + head) * 128 + e0 + nt * 16 + l15)) * 256 + t) = pk;
                    }
                } else {
                    const int s = (r0 - 4096) >> 10, t = (r0 - 4096) & 1023;
#pragma unroll
                    for (int nt = 0; nt < 4; ++nt) {
                        uint2 pk; pk.x = pack2(acc[mt][nt][0], acc[mt][nt][1]); pk.y = pack2(acc[mt][nt][2], acc[mt][nt][3]);
                        *(uint2*)((bf16_t*)(ws + OFF_VTS) + ((size_t)((s * 8 + head) * 128 + e0 + nt * 16 + l15)) * 1536 + 512 + t) = pk;
                    }
                }
            }
        } else {
            if (wc == 0) {
                float* DR = (float*)(ws + OFF_DTRAW);
#pragma unroll
                for (int mt = 0; mt < 4; ++mt)
#pragma unroll
                    for (int nt = 0; nt < 2; ++nt)
#pragma unroll
                        for (int j = 0; j < 4; ++j) DR[(size_t)(rbase + mt * 16 + j) * 32 + nt * 16 + l15] = acc[mt][nt][j];
            }
        }
    }
};

struct EpiResid {
    float* X; const float* gate; const float* bias; int m0, n0;
    DEVI void operator()(const f32x4 (&acc)[4][4], int wr, int wc, int l15, int quad) const {
        const int rbase = m0 + wr * 64 + quad * 4, cw = n0 + wc * 64;
        const float* gt = gate + (size_t)rowgrp(m0) * 6144;
#pragma unroll
        for (int nt = 0; nt < 4; ++nt) {
            const int c = cw + nt * 16 + l15;
            const float g = gt[c], b = bias ? bias[c] : 0.f;
#pragma unroll
            for (int mt = 0; mt < 4; ++mt)
#pragma unroll
                for (int j = 0; j < 4; ++j) { float* xp = X + (size_t)(rbase + mt * 16 + j) * 1024 + c; *xp = *xp + g * (acc[mt][nt][j] + b); }
        }
    }
};

struct EpiSwiglu {
    bf16_t* HID; int m0, jt;
    DEVI void operator()(const f32x4 (&acc)[4][4], int wr, int wc, int l15, int quad) const {
        const int rbase = m0 + wr * 64 + quad * 4, hc = jt * 64 + wc * 32;
#pragma unroll
        for (int mt = 0; mt < 4; ++mt)
#pragma unroll
            for (int nt = 0; nt < 2; ++nt)
#pragma unroll
                for (int j = 0; j < 4; ++j)
                    HID[(size_t)(rbase + mt * 16 + j) * FH + hc + nt * 16 + l15] = f2bf(siluf(acc[mt][nt][j]) * acc[mt][nt + 2][j]);
    }
};

struct EpiDftC {
    bf16_t* UVt; int L, tbase, g, nn0;
    DEVI void operator()(const f32x4 (&acc)[4][4], int wr, int wc, int l15, int quad) const {
#pragma unroll
        for (int nt = 0; nt < 4; ++nt) {
            const int n = nn0 + wc * 64 + nt * 16 + l15, isv = n >> 8, ch = g * 256 + (n & 255);
            bf16_t* rowp = UVt + (size_t)ch * (2 * L) + isv * L + tbase + wr * 64 + quad * 4;
#pragma unroll
            for (int mt = 0; mt < 4; ++mt) {
                uint2 pk; pk.x = pack2(acc[mt][nt][0], acc[mt][nt][1]); pk.y = pack2(acc[mt][nt][2], acc[mt][nt][3]);
                *(uint2*)(rowp + mt * 16) = pk;
            }
        }
    }
};

struct EpiBf16 {
    bf16_t* O; int ldo, m0, n0;
    DEVI void operator()(const f32x4 (&acc)[4][4], int wr, int wc, int l15, int quad) const {
        const int rbase = m0 + wr * 64 + quad * 4, cw = n0 + wc * 64;
#pragma unroll
        for (int mt = 0; mt < 4; ++mt)
#pragma unroll
            for (int nt = 0; nt < 4; ++nt)
#pragma unroll
                for (int j = 0; j < 4; ++j) O[(size_t)(rbase + mt * 16 + j) * ldo + cw + nt * 16 + l15] = f2bf(acc[mt][nt][j]);
    }
};

DEVI int map_in(int n) { return n < 3072 ? n : (n < 6144 ? n + 32 : (n < 6176 ? n - 3072 : -1)); }
DEVI int map_ffn(int n) { const int j = n >> 7, wc = (n >> 6) & 1, nt = (n >> 4) & 3, c = n & 15; return ((nt & 2) ? FH : 0) + j * 64 + wc * 32 + (nt & 1) * 16 + c; }

DEVI void cvt_item(const float* __restrict__ src, int ldsrc, bf16_t* __restrict__ dst, int K, int n64, int k32, int kind, int lane) {
    const int n = n64 * 64 + (lane & 15) * 4, k = k32 * 32 + (lane >> 4) * 8;
    const int sc = kind == 1 ? map_in(n) : (kind == 2 ? map_ffn(n) : n);
    float4 v[8];
#pragma unroll
    for (int j = 0; j < 8; ++j) v[j] = sc >= 0 ? *(const float4*)(src + (size_t)(k + j) * ldsrc + sc) : make_float4(0.f, 0.f, 0.f, 0.f);
    uint4 o;
    o.x = pack2(v[0].x, v[1].x); o.y = pack2(v[2].x, v[3].x); o.z = pack2(v[4].x, v[5].x); o.w = pack2(v[6].x, v[7].x); *(uint4*)(dst + (size_t)(n + 0) * K + k) = o;
    o.x = pack2(v[0].y, v[1].y); o.y = pack2(v[2].y, v[3].y); o.z = pack2(v[4].y, v[5].y); o.w = pack2(v[6].y, v[7].y); *(uint4*)(dst + (size_t)(n + 1) * K + k) = o;
    o.x = pack2(v[0].z, v[1].z); o.y = pack2(v[2].z, v[3].z); o.z = pack2(v[4].z, v[5].z); o.w = pack2(v[6].z, v[7].z); *(uint4*)(dst + (size_t)(n + 2) * K + k) = o;
    o.x = pack2(v[0].w, v[1].w); o.y = pack2(v[2].w, v[3].w); o.z = pack2(v[4].w, v[5].w); o.w = pack2(v[6].w, v[7].w); *(uint4*)(dst + (size_t)(n + 3) * K + k) = o;
}

DEVI int cvt_layer_count(int l) { return (l & 1) ? 4736 : 8384; }
DEVI void cvt_layer_item(const P& p, int l, int it, int lane) {
    char* ws = p.ws;
    if ((l & 1) == 0) {
        const int e = l >> 1;
        if (it < 3136) { cvt_item(p.w_in_ab + (size_t)e * 1024 * 6176, 6176, (bf16_t*)(ws + OFF_WTIN) + (size_t)e * NIN * 1024, 1024, it >> 5, it & 31, 1, lane); return; }
        it -= 3136;
        if (it < 1024) { cvt_item(p.w_out_ab + (size_t)e * 2048 * 1024, 1024, (bf16_t*)(ws + OFF_WTOUT) + (size_t)e * 1024 * 2048, 2048, it >> 6, it & 63, 0, lane); return; }
        it -= 1024;
    } else {
        const int o = l >> 1;
        if (it < 512) { cvt_item(p.w_four + (size_t)o * 1024 * 1024, 1024, (bf16_t*)(ws + OFF_WTFOUR) + (size_t)o * 1024 * 1024, 1024, it >> 5, it & 31, 0, lane); return; }
        it -= 512;
    }
    if (it < 2816) { cvt_item(p.w_ffn_in + (size_t)l * 1024 * 5632, 5632, (bf16_t*)(ws + OFF_WTFIN) + (size_t)l * 5632 * 1024, 1024, it >> 5, it & 31, 2, lane); return; }
    it -= 2816;
    cvt_item(p.w_ffn_out + (size_t)l * 2816 * 1024, 1024, (bf16_t*)(ws + OFF_WTFOUT) + (size_t)l * 1024 * 2816, 2816, it / 88, it % 88, 0, lane);
}

DEVI void phase_pre(const P& p, char* smem) {
    char* ws = p.ws;
    const int tid = threadIdx.x, lane = tid & 63, wib = tid >> 6;
    const int gw = blockIdx.x * 4 + wib, nw = gridDim.x * 4;
    const int gt = blockIdx.x * 256 + tid, nt = gridDim.x * 256;
    {
        float* sv = (float*)smem;
        float* part = sv + 5 * 1024;
        for (int i = tid; i < 5 * 1024; i += 256) { const int g = i >> 10, k = i & 1023; sv[i] = siluf(g == 0 ? p.c_ctx[k] : p.c[(g - 1) * 1024 + k]); }
        __syncthreads();
        float* MOD = (float*)(ws + OFF_MOD);
        for (int it = blockIdx.x; it < 384; it += gridDim.x) {
            const int l = it / 96, col = (it % 96) * 64 + lane;
            const float* wp = p.w_ada + (size_t)l * 1024 * 6144 + (size_t)(wib * 256) * 6144 + col;
            float a0 = 0.f, a1 = 0.f, a2 = 0.f, a3 = 0.f, a4 = 0.f;
#pragma unroll 8
            for (int k = 0; k < 256; ++k) {
                const float wv = wp[(size_t)k * 6144]; const int kk = wib * 256 + k;
                a0 += sv[kk] * wv; a1 += sv[1024 + kk] * wv; a2 += sv[2048 + kk] * wv; a3 += sv[3072 + kk] * wv; a4 += sv[4096 + kk] * wv;
            }
            part[(wib * 5 + 0) * 64 + lane] = a0; part[(wib * 5 + 1) * 64 + lane] = a1; part[(wib * 5 + 2) * 64 + lane] = a2;
            part[(wib * 5 + 3) * 64 + lane] = a3; part[(wib * 5 + 4) * 64 + lane] = a4;
            __syncthreads();
            for (int i = tid; i < 320; i += 256) {
                const int g = i >> 6, cl = i & 63, cc = (it % 96) * 64 + cl;
                MOD[((size_t)l * 5 + g) * 6144 + cc] = part[(0 * 5 + g) * 64 + cl] + part[(1 * 5 + g) * 64 + cl] + part[(2 * 5 + g) * 64 + cl] + part[(3 * 5 + g) * 64 + cl] + p.b_ada[(size_t)l * 6144 + cc];
            }
            __syncthreads();
        }
    }
    for (int it = gw; it < 8384; it += nw) cvt_layer_item(p, 0, it, lane);
    {
        float4* X4 = (float4*)(ws + OFF_X);
        const float4* a = (const float4*)p.x_prompt; const float4* b = (const float4*)p.x_sample;
        for (int i = gt; i < 1048576; i += nt) { X4[i] = a[i]; X4[1048576 + i] = b[i]; }
    }
    {
        bf16_t* DL = (bf16_t*)(ws + OFF_DL1024);
        for (int i = gt; i < 1024 * 2048; i += nt) {
            const int lp = i >> 11, k = i & 2047, l = k & 1023; const float x = (float)((lp * l) & 1023) * (1.f / 1024.f);
            DL[i] = f2bf((k < 1024 ? __builtin_amdgcn_cosf(x) : -__builtin_amdgcn_sinf(x)) * (1.f / 32.f));
        }
        bf16_t* DS = (bf16_t*)(ws + OFF_DL256);
        for (int i = gt; i < 256 * 512; i += nt) {
            const int lp = i >> 9, k = i & 511, l = k & 255; const float x = (float)((lp * l) & 255) * (1.f / 256.f);
            DS[i] = f2bf((k < 256 ? __builtin_amdgcn_cosf(x) : -__builtin_amdgcn_sinf(x)) * (1.f / 16.f));
        }
        bf16_t* DC = (bf16_t*)(ws + OFF_DC);
        for (int i = gt; i < 512 * 256; i += nt) {
            const int n = i >> 8, k = i & 255; const float x = (float)(((n & 255) * k) & 255) * (1.f / 256.f);
            DC[i] = f2bf((n < 256 ? __builtin_amdgcn_cosf(x) : __builtin_amdgcn_sinf(x)) * (1.f / 16.f));
        }
        float* rope = (float*)(ws + OFF_ROPE);
        for (int i = gt; i < 1024; i += nt) {
            const int pos = i >> 4, fi = i & 15;
            const float freq = exp2f(-(float)fi * (13.287712379549449f / 16.f));
            const float turns = (float)pos * freq * 0.15915494309189535f;
            rope[i * 2] = __builtin_amdgcn_cosf(turns); rope[i * 2 + 1] = __builtin_amdgcn_sinf(turns);
        }
        if (gt < 2) {
            const float* lq = p.lambda_qk + gt * 256; float s1 = 0.f, s2 = 0.f;
            for (int d = 0; d < 64; ++d) { s1 += lq[d] * lq[64 + d]; s2 += lq[128 + d] * lq[192 + d]; }
            const float li = gt == 0 ? 0.2f : 0.8f - 0.6f * 0.5488116360940264f;
            ((float*)(ws + OFF_LAM))[gt] = __expf(s1) - __expf(s2) + li;
        }
    }
}

DEVI void phase_norm(const P& p, int l, int which) {
    char* ws = p.ws;
    const int lane = threadIdx.x & 63, gw = blockIdx.x * 4 + (threadIdx.x >> 6), nw = gridDim.x * 4;
    const float* X = (const float*)(ws + OFF_X);
    const float* gam = which == 0 ? p.norm_mix + l * 1024 : (which == 1 ? p.norm_ffn + l * 1024 : p.norm_final);
    for (int r0 = gw * 4; r0 < T_ALL; r0 += nw * 4) {
        float4 v[4][4]; float ss[4];
#pragma unroll
        for (int q = 0; q < 4; ++q) {
            const float4* xr = (const float4*)(X + (size_t)(r0 + q) * 1024);
#pragma unroll
            for (int i = 0; i < 4; ++i) v[q][i] = xr[lane + i * 64];
        }
#pragma unroll
        for (int q = 0; q < 4; ++q) {
            float s = 0.f;
#pragma unroll
            for (int i = 0; i < 4; ++i) s += v[q][i].x * v[q][i].x + v[q][i].y * v[q][i].y + v[q][i].z * v[q][i].z + v[q][i].w * v[q][i].w;
            ss[q] = s;
        }
#pragma unroll
        for (int o = 32; o > 0; o >>= 1) {
#pragma unroll
            for (int q = 0; q < 4; ++q) ss[q] += __shfl_xor(ss[q], o);
        }
        float rstd[4];
#pragma unroll
        for (int q = 0; q < 4; ++q) rstd[q] = rsqrtf(ss[q] * (1.f / 1024.f) + 1e-6f);
        if (which == 2) {
#pragma unroll
            for (int i = 0; i < 4; ++i) {
                const float4 g = ((const float4*)gam)[lane + i * 64];
#pragma unroll
                for (int q = 0; q < 4; ++q) { float4 y; y.x = v[q][i].x * rstd[q] * g.x; y.y = v[q][i].y * rstd[q] * g.y; y.z = v[q][i].z * rstd[q] * g.z; y.w = v[q][i].w * rstd[q] * g.w;
                    ((float4*)(p.out + (size_t)(r0 + q) * 1024))[lane + i * 64] = y; }
            }
        } else {
            const float* md = (const float*)(ws + OFF_MOD) + ((size_t)l * 5 + rowgrp(r0)) * 6144 + (which ? 3072 : 0);
#pragma unroll
            for (int i = 0; i < 4; ++i) {
                const float4 g = ((const float4*)gam)[lane + i * 64], sh = ((const float4*)md)[lane + i * 64], sc = ((const float4*)(md + 1024))[lane + i * 64];
                const float gx = g.x * (1.f + sc.x), gy = g.y * (1.f + sc.y), gz = g.z * (1.f + sc.z), gw2 = g.w * (1.f + sc.w);
#pragma unroll
                for (int q = 0; q < 4; ++q) {
                    uint2 pk; pk.x = pack2(v[q][i].x * rstd[q] * gx + sh.x, v[q][i].y * rstd[q] * gy + sh.y);
                    pk.y = pack2(v[q][i].z * rstd[q] * gz + sh.z, v[q][i].w * rstd[q] * gw2 + sh.w);
                    ((uint2*)((bf16_t*)(ws + OFF_HBF) + (size_t)(r0 + q) * 1024))[lane + i * 64] = pk;
                }
            }
        }
    }
}

DEVI void phase_ctx(const P& p, int e) {
    char* ws = p.ws;
    const int gt = blockIdx.x * 256 + threadIdx.x, nt = gridDim.x * 256;
    bf16_t* KS = (bf16_t*)(ws + OFF_KS); bf16_t* VTS = (bf16_t*)(ws + OFF_VTS);
    for (int i = gt; i < 4 * 512 * 8 * 16; i += nt) {
        const int c8 = i & 15, h = (i >> 4) & 7, pos = (i >> 7) & 511, s = i >> 16;
        const float* src = p.cache_k + ((size_t)((s * 2 + e) * 512 + pos)) * 1024 + h * 128 + c8 * 8;
        const float4 a = *(const float4*)src, b = *(const float4*)(src + 4);
        uint4 o; o.x = pack2(a.x, a.y); o.y = pack2(a.z, a.w); o.z = pack2(b.x, b.y); o.w = pack2(b.z, b.w);
        *(uint4*)(KS + ((size_t)((s * 8 + h) * 1536 + pos)) * 128 + c8 * 8) = o;
    }
    for (int i = gt; i < 4 * 8 * 64 * 128; i += nt) {
        const int ee = i & 127, p8 = (i >> 7) & 63, h = (i >> 13) & 7, s = i >> 16;
        const float* src = p.cache_v + ((size_t)((s * 2 + e) * 512 + p8 * 8)) * 1024 + h * 128 + ee;
        float v[8];
#pragma unroll
        for (int j = 0; j < 8; ++j) v[j] = src[(size_t)j * 1024];
        uint4 o; o.x = pack2(v[0], v[1]); o.y = pack2(v[2], v[3]); o.z = pack2(v[4], v[5]); o.w = pack2(v[6], v[7]);
        *(uint4*)(VTS + ((size_t)((s * 8 + h) * 128 + ee)) * 1536 + p8 * 8) = o;
    }
}

DEVI void phase_conv(const P& p, int e) {
    char* ws = p.ws;
    const int gt = blockIdx.x * 256 + threadIdx.x, nt = gridDim.x * 256;
    const bf16_t* XB = (const bf16_t*)(ws + OFF_XBC); bf16_t* XC = (bf16_t*)(ws + OFF_XBCC);
    const float* cw = p.conv_w + (size_t)e * 5 * 2048; const float* cb = p.conv_b + (size_t)e * 2048;
    for (int i = gt; i < T_ALL * 256; i += nt) {
        const int c8 = (i & 255) * 8, r = i >> 8;
        int t, L; if (r < 4096) { t = r & 255; L = 256; } else { t = (r - 4096) & 1023; L = 1024; }
        float acc[8];
#pragma unroll
        for (int j = 0; j < 8; ++j) acc[j] = cb[c8 + j];
#pragma unroll
        for (int wq = 0; wq < 5; ++wq) {
            const int tt = t + wq - 2;
            if (tt >= 0 && tt < L) {
                const uint4 u = *(const uint4*)(XB + (size_t)(r + wq - 2) * 2048 + c8);
                const float4 w0 = *(const float4*)(cw + wq * 2048 + c8), w1 = *(const float4*)(cw + wq * 2048 + c8 + 4);
                acc[0] += w0.x * __uint_as_float(u.x << 16); acc[1] += w0.y * __uint_as_float(u.x & 0xffff0000u);
                acc[2] += w0.z * __uint_as_float(u.y << 16); acc[3] += w0.w * __uint_as_float(u.y & 0xffff0000u);
                acc[4] += w1.x * __uint_as_float(u.z << 16); acc[5] += w1.y * __uint_as_float(u.z & 0xffff0000u);
                acc[6] += w1.z * __uint_as_float(u.w << 16); acc[7] += w1.w * __uint_as_float(u.w & 0xffff0000u);
            }
        }
        uint4 o; o.x = pack2(siluf(acc[0]), siluf(acc[1])); o.y = pack2(siluf(acc[2]), siluf(acc[3])); o.z = pack2(siluf(acc[4]), siluf(acc[5])); o.w = pack2(siluf(acc[6]), siluf(acc[7]));
        *(uint4*)(XC + (size_t)r * 2048 + c8) = o;
    }
    const float* DR = (const float*)(ws + OFF_DTRAW); float* DTp = (float*)(ws + OFF_DT);
    for (int i = gt; i < T_ALL * 32; i += nt) {
        const float x = DR[i] + p.dt_bias[e * 32 + (i & 31)];
        DTp[i] = x > 20.f ? x : log1pf(__expf(x));
    }
}

DEVI void attn_item(const P& p, int e, int it, char* smem) {
    char* ws = p.ws;
    const int tid = threadIdx.x, lane = tid & 63, w = tid >> 6, l15 = lane & 15, quad = lane >> 4;
    const int map = w & 1, rg = w >> 1;
    bf16_t* Ks = (bf16_t*)smem;
    bf16_t* Vs = Ks + 64 * 128;
    bf16_t* Ps = Vs + 128 * 64 + w * 32 * 64;
    const float sscale = 0.125f * 1.4426950408889634f;
    int r0, Lk, h; const bf16_t* Kg; const bf16_t* Vg;
    if (it < 512) { const int s = it >> 7, qb = it & 15; h = (it >> 4) & 7; r0 = 4096 + s * 1024 + qb * 64; Lk = 1536;
        Kg = (const bf16_t*)(ws + OFF_KS) + (size_t)(s * 8 + h) * 1536 * 128; Vg = (const bf16_t*)(ws + OFF_VTS) + (size_t)(s * 8 + h) * 128 * 1536; }
    else { const int i2 = it - 512, b = i2 >> 5, qb = i2 & 3; h = (i2 >> 2) & 7; r0 = b * 256 + qb * 64; Lk = 256;
        Kg = (const bf16_t*)(ws + OFF_KP) + (size_t)(b * 8 + h) * 256 * 128; Vg = (const bf16_t*)(ws + OFF_VTP) + (size_t)(b * 8 + h) * 128 * 256; }
    bf16x8 qf[2][2];
    {
        const bf16_t* qp = (const bf16_t*)(ws + OFF_Q) + (size_t)(r0 + rg * 32 + l15) * 1024 + h * 128 + map * 64 + quad * 8;
#pragma unroll
        for (int mt = 0; mt < 2; ++mt)
#pragma unroll
            for (int ks = 0; ks < 2; ++ks) qf[mt][ks] = *(const bf16x8*)(qp + (size_t)mt * 16 * 1024 + ks * 32);
    }
    f32x4 oacc[2][8];
    float mrow[2], lrow[2];
#pragma unroll
    for (int mt = 0; mt < 2; ++mt) {
#pragma unroll
        for (int i = 0; i < 8; ++i) oacc[mt][i] = (f32x4){0.f, 0.f, 0.f, 0.f};
        mrow[mt] = -1e30f; lrow[mt] = 0.f;
    }
    const int krow = tid >> 4, kc = tid & 15, vrow = tid >> 3, vc = tid & 7;
    const bf16_t* kgp = Kg + (size_t)krow * 128 + kc * 8;
    const bf16_t* vgp = Vg + (size_t)vrow * Lk + vc * 8;
    const int kso = krow * 128 + ((kc ^ (krow & 15)) * 8);
    const int vso = vrow * 64 + ((vc ^ ((vrow >> 1) & 7)) * 8);
    uint4 rk0, rk1, rk2, rk3;
#define ATT_LDK(kn) do { const bf16_t* kq_ = kgp + (size_t)(kn) * 64 * 128; \
        rk0 = *(const uint4*)(kq_); rk1 = *(const uint4*)(kq_ + 16 * 128); rk2 = *(const uint4*)(kq_ + 32 * 128); rk3 = *(const uint4*)(kq_ + 48 * 128); } while (0)
#define ATT_LDV(kn) const bf16_t* vq_ = vgp + (kn) * 64; \
        const uint4 rv0 = *(const uint4*)(vq_), rv1 = *(const uint4*)(vq_ + (size_t)32 * Lk), rv2 = *(const uint4*)(vq_ + (size_t)64 * Lk), rv3 = *(const uint4*)(vq_ + (size_t)96 * Lk);
    ATT_LDK(0);
    const int nkt = Lk >> 6;
    const int vsw = (l15 >> 1) & 7;
    for (int kt = 0; kt < nkt; ++kt) {
        __syncthreads();
        *(uint4*)(Ks + kso) = rk0; *(uint4*)(Ks + kso + 16 * 128) = rk1; *(uint4*)(Ks + kso + 32 * 128) = rk2; *(uint4*)(Ks + kso + 48 * 128) = rk3;
        { ATT_LDV(kt); *(uint4*)(Vs + vso) = rv0; *(uint4*)(Vs + vso + 32 * 64) = rv1; *(uint4*)(Vs + vso + 64 * 64) = rv2; *(uint4*)(Vs + vso + 96 * 64) = rv3; }
        __syncthreads();
        const int kn = kt + 1 < nkt ? kt + 1 : kt;
        ATT_LDK(kn);
        f32x4 sc[2][4];
#pragma unroll
        for (int mt = 0; mt < 2; ++mt)
#pragma unroll
            for (int nt = 0; nt < 4; ++nt) sc[mt][nt] = (f32x4){0.f, 0.f, 0.f, 0.f};
#pragma unroll
        for (int ks = 0; ks < 2; ++ks)
#pragma unroll
            for (int nt = 0; nt < 4; ++nt) {
                const bf16x8 kb = lds_frag(Ks + (nt * 16 + l15) * 128 + (((map * 8 + ks * 4 + quad) ^ l15) * 8));
                sc[0][nt] = mfma16(kb, qf[0][ks], sc[0][nt]);
                sc[1][nt] = mfma16(kb, qf[1][ks], sc[1][nt]);
            }
        bf16x8 pf[2][2];
#pragma unroll
        for (int mt = 0; mt < 2; ++mt) {
            float mx = sc[mt][0][0];
#pragma unroll
            for (int nt = 0; nt < 4; ++nt)
#pragma unroll
                for (int j = 0; j < 4; ++j) mx = fmaxf(mx, sc[mt][nt][j]);
            mx *= sscale;
            mx = fmaxf(mx, __shfl_xor(mx, 16)); mx = fmaxf(mx, __shfl_xor(mx, 32));
            const bool need = mx > mrow[mt] + 8.f;
            const float mnew = need ? mx : mrow[mt], alpha = need ? __builtin_amdgcn_exp2f(mrow[mt] - mnew) : 1.f;
            mrow[mt] = mnew;
            float ps = 0.f;
#pragma unroll
            for (int nt = 0; nt < 4; ++nt)
#pragma unroll
                for (int j = 0; j < 4; ++j) { const float pv = __builtin_amdgcn_exp2f(sc[mt][nt][j] * sscale - mnew); sc[mt][nt][j] = pv; ps += pv; }
            lrow[mt] = lrow[mt] * alpha + ps;
#pragma unroll
            for (int g = 0; g < 2; ++g) {
                union { unsigned u[4]; bf16x8 v; } cv;
                cv.u[0] = pack2(sc[mt][2 * g][0], sc[mt][2 * g][1]); cv.u[1] = pack2(sc[mt][2 * g][2], sc[mt][2 * g][3]);
                cv.u[2] = pack2(sc[mt][2 * g + 1][0], sc[mt][2 * g + 1][1]); cv.u[3] = pack2(sc[mt][2 * g + 1][2], sc[mt][2 * g + 1][3]);
                pf[mt][g] = cv.v;
            }
            if (__any(need)) {
#pragma unroll
                for (int i = 0; i < 8; ++i) { oacc[mt][i][0] *= alpha; oacc[mt][i][1] *= alpha; oacc[mt][i][2] *= alpha; oacc[mt][i][3] *= alpha; }
            }
        }
#pragma unroll
        for (int g = 0; g < 2; ++g) {
            const int c0 = g * 4 + (quad >> 1), hf = (quad & 1) * 4;
#pragma unroll
            for (int i = 0; i < 8; ++i) {
                const bf16_t* vr = Vs + (i * 16 + l15) * 64 + hf;
                union { uint2 h[2]; bf16x8 v; } vv;
                vv.h[0] = *(const uint2*)(vr + ((c0 ^ vsw) * 8));
                vv.h[1] = *(const uint2*)(vr + (((c0 + 2) ^ vsw) * 8));
                oacc[0][i] = mfma16(vv.v, pf[0][g], oacc[0][i]);
                oacc[1][i] = mfma16(vv.v, pf[1][g], oacc[1][i]);
            }
        }
    }
    const float lam = ((const float*)(ws + OFF_LAM))[e];
    const float linit = e == 0 ? 0.2f : 0.8f - 0.6f * 0.5488116360940264f;
    float* Ex = (float*)smem + rg * 32 * 128;
    __syncthreads();
    float linv[2];
#pragma unroll
    for (int mt = 0; mt < 2; ++mt) { float l = lrow[mt]; l += __shfl_xor(l, 16); l += __shfl_xor(l, 32); linv[mt] = (map == 1 ? lam : 1.f) / l; }
    if (map == 1) {
#pragma unroll
        for (int mt = 0; mt < 2; ++mt)
#pragma unroll
            for (int i = 0; i < 8; ++i) {
                f32x4 v = oacc[mt][i]; v[0] *= linv[mt]; v[1] *= linv[mt]; v[2] *= linv[mt]; v[3] *= linv[mt];
                *(f32x4*)(Ex + (mt * 16 + l15) * 128 + i * 16 + quad * 4) = v;
            }
    }
    __syncthreads();
    if (map == 0) {
        const float* subln = p.subln + e * 128;
        bf16_t* OC = (bf16_t*)(ws + OFF_OCAT);
#pragma unroll
        for (int mt = 0; mt < 2; ++mt) {
            f32x4 o[8]; float ss = 0.f;
#pragma unroll
            for (int i = 0; i < 8; ++i) {
                const f32x4 x = *(const f32x4*)(Ex + (mt * 16 + l15) * 128 + i * 16 + quad * 4);
#pragma unroll
                for (int j = 0; j < 4; ++j) { o[i][j] = oacc[mt][i][j] * linv[mt] - x[j]; ss += o[i][j] * o[i][j]; }
            }
            ss += __shfl_xor(ss, 16); ss += __shfl_xor(ss, 32);
            const float rstd = rsqrtf(ss * (1.f / 128.f) + 1e-6f) * (1.f - linit);
            bf16_t* op = OC + (size_t)(r0 + rg * 32 + mt * 16 + l15) * 2048 + 1024 + h * 128 + quad * 4;
#pragma unroll
            for (int i = 0; i < 8; ++i) {
                const f32x4 g = *(const f32x4*)(subln + i * 16 + quad * 4);
                uint2 pk; pk.x = pack2(o[i][0] * rstd * g[0], o[i][1] * rstd * g[1]); pk.y = pack2(o[i][2] * rstd * g[2], o[i][3] * rstd * g[3]);
                *(uint2*)(op + i * 16) = pk;
            }
        }
    }
}

typedef short s16x4 __attribute__((ext_vector_type(4)));
DEVI bf16x8 tr_frag(const bf16_t* tile, int stride, int r0, int c0, int l15, int quad) {
    const bf16_t* a = tile + (r0 + quad * 8 + (l15 >> 2)) * stride + c0 + 4 * (l15 & 3);
    const s16x4 lo = __builtin_amdgcn_ds_read_tr16_b64_v4i16((LAS s16x4*)a);
    const s16x4 hi = __builtin_amdgcn_ds_read_tr16_b64_v4i16((LAS s16x4*)(a + 4 * stride));
    bf16x8 r; r[0] = lo[0]; r[1] = lo[1]; r[2] = lo[2]; r[3] = lo[3]; r[4] = hi[0]; r[5] = hi[1]; r[6] = hi[2]; r[7] = hi[3];
    return r;
}
DEVI void ssd_item(const P& p, int e, int it, char* smem) {
    char* ws = p.ws;
    const int tid = threadIdx.x, lane = tid & 63, w = tid >> 6, l15 = lane & 15, quad = lane >> 4;
    bf16_t* Cs = (bf16_t*)smem;
    bf16_t* Bs = Cs + 64 * 136;
    bf16_t* Hs = Bs + 64 * 136;
    bf16_t* Xs = Hs + 64 * 136;
    bf16_t* Ws = Xs + 64 * 72;
    float* facs = (float*)(Ws + 64 * 72);
    float* ftend = facs + 64;
    const bf16_t* XC = (const bf16_t*)(ws + OFF_XBCC);
    const float* DTp = (const float*)(ws + OFF_DT);
    {
        int seq, h, dir, L, rowbase;
        if (it < 128) { const int s = it >> 5; h = (it >> 1) & 15; dir = it & 1; seq = 16 + s; L = 1024; rowbase = 4096 + s * 1024; }
        else { const int i2 = it - 128; seq = i2 >> 5; h = (i2 >> 1) & 15; dir = i2 & 1; L = 256; rowbase = seq * 256; }
        const int g = h >> 2;
        const float a = -__expf(p.a_log[e * 32 + dir * 16 + h]);
        bf16_t* Y = (bf16_t*)(ws + (dir ? OFF_YB : OFF_YF));
        f32x4 hst[8];
        if (seq >= 16) {
            const float* h0 = (dir ? p.st_b : p.st_f) + ((size_t)(((seq - 16) * 2 + e) * 16 + h)) * 64 * 128;
#pragma unroll
            for (int nt = 0; nt < 8; ++nt)
#pragma unroll
                for (int j = 0; j < 4; ++j) hst[nt][j] = h0[(size_t)(16 * w + quad * 4 + j) * 128 + nt * 16 + l15];
        } else {
#pragma unroll
            for (int nt = 0; nt < 8; ++nt) hst[nt] = (f32x4){0.f, 0.f, 0.f, 0.f};
        }
        const int nch = L >> 6;
        for (int c = 0; c < nch; ++c) {
            __syncthreads();
#pragma unroll
            for (int i = 0; i < 4; ++i) {
                const int id = tid + i * 256, row = id >> 4, cc = id & 15;
                const int pos = c * 64 + row, t = dir ? L - 1 - pos : pos;
                const bf16_t* src = XC + (size_t)(rowbase + t) * 2048;
                *(uint4*)(Bs + row * 136 + cc * 8) = *(const uint4*)(src + 1024 + g * 128 + cc * 8);
                *(uint4*)(Cs + row * 136 + cc * 8) = *(const uint4*)(src + 1536 + g * 128 + cc * 8);
            }
#pragma unroll
            for (int i = 0; i < 2; ++i) {
                const int id = tid + i * 256, row = id >> 3, cc = id & 7;
                const int pos = c * 64 + row, t = dir ? L - 1 - pos : pos;
                const uint4 u = *(const uint4*)(XC + (size_t)(rowbase + t) * 2048 + h * 64 + cc * 8);
                const float dtv = DTp[(size_t)(rowbase + t) * 32 + dir * 16 + h];
                uint4 o;
                o.x = pack2(dtv * __uint_as_float(u.x << 16), dtv * __uint_as_float(u.x & 0xffff0000u));
                o.y = pack2(dtv * __uint_as_float(u.y << 16), dtv * __uint_as_float(u.y & 0xffff0000u));
                o.z = pack2(dtv * __uint_as_float(u.z << 16), dtv * __uint_as_float(u.z & 0xffff0000u));
                o.w = pack2(dtv * __uint_as_float(u.w << 16), dtv * __uint_as_float(u.w & 0xffff0000u));
                *(uint4*)(Xs + row * 72 + cc * 8) = o;
            }
            if (w == 0) {
                const int pos = c * 64 + lane, t = dir ? L - 1 - pos : pos;
                float v = a * DTp[(size_t)(rowbase + t) * 32 + dir * 16 + h];
#pragma unroll
                for (int o = 1; o < 64; o <<= 1) { const float tv = __shfl_up(v, o); if (lane >= o) v += tv; }
                facs[lane] = v;
                ftend[lane] = __expf(__shfl(v, 63) - v);
            }
#pragma unroll
            for (int nt = 0; nt < 8; ++nt)
#pragma unroll
                for (int j = 0; j < 4; ++j) Hs[(16 * w + quad * 4 + j) * 136 + nt * 16 + l15] = f2bf(hst[nt][j]);
            __syncthreads();
            f32x4 sacc[4], yacc[4];
#pragma unroll
            for (int nt = 0; nt < 4; ++nt) { sacc[nt] = (f32x4){0.f, 0.f, 0.f, 0.f}; yacc[nt] = (f32x4){0.f, 0.f, 0.f, 0.f}; }
#pragma unroll
            for (int ks = 0; ks < 4; ++ks) {
                const bf16x8 cf = lds_frag(Cs + (16 * w + l15) * 136 + ks * 32 + quad * 8);
#pragma unroll
                for (int nt = 0; nt < 4; ++nt) {
                    sacc[nt] = mfma16(cf, lds_frag(Bs + (nt * 16 + l15) * 136 + ks * 32 + quad * 8), sacc[nt]);
                    yacc[nt] = mfma16(cf, lds_frag(Hs + (nt * 16 + l15) * 136 + ks * 32 + quad * 8), yacc[nt]);
                }
            }
            const float alast = facs[63];
#pragma unroll
            for (int j = 0; j < 4; ++j) {
                const int i = 16 * w + quad * 4 + j; const float ai = facs[i], ei = __expf(ai);
#pragma unroll
                for (int nt = 0; nt < 4; ++nt) {
                    const int jj = nt * 16 + l15;
                    const float wv = jj <= i ? sacc[nt][j] * __expf(fminf(ai - facs[jj], 0.f)) : 0.f;
                    Ws[i * 72 + jj] = f2bf(wv);
                    yacc[nt][j] *= ei;
                }
            }
            asm volatile("s_waitcnt lgkmcnt(0)" ::: "memory");
#pragma unroll
            for (int ks = 0; ks < 2; ++ks) {
                const bf16x8 wf = lds_frag(Ws + (16 * w + l15) * 72 + ks * 32 + quad * 8);
#pragma unroll
                for (int nt = 0; nt < 4; ++nt) yacc[nt] = mfma16(wf, tr_frag(Xs, 72, ks * 32, nt * 16, l15, quad), yacc[nt]);
            }
#pragma unroll
            for (int j = 0; j < 4; ++j) {
                const int i = 16 * w + quad * 4 + j, pos = c * 64 + i, t = dir ? L - 1 - pos : pos;
                bf16_t* yp = Y + (size_t)(rowbase + t) * 1024 + h * 64;
#pragma unroll
                for (int nt = 0; nt < 4; ++nt) yp[nt * 16 + l15] = f2bf(yacc[nt][j]);
            }
            {
                const float dec = __expf(alast);
#pragma unroll
                for (int nt = 0; nt < 8; ++nt) { hst[nt][0] *= dec; hst[nt][1] *= dec; hst[nt][2] *= dec; hst[nt][3] *= dec; }
#pragma unroll
                for (int ks = 0; ks < 2; ++ks) {
                    bf16x8 xa = tr_frag(Xs, 72, ks * 32, 16 * w, l15, quad);
#pragma unroll
                    for (int q = 0; q < 8; ++q) {
                        const int jj = ks * 32 + quad * 8 + q;
                        xa[q] = (short)f2bf(bf2f((bf16_t)xa[q]) * ftend[jj]);
                    }
#pragma unroll
                    for (int nt = 0; nt < 8; ++nt) hst[nt] = mfma16(xa, tr_frag(Bs, 136, ks * 32, nt * 16, l15, quad), hst[nt]);
                }
            }
        }
        if (seq < 16) {
            float* o = p.out + (dir ? 29360128 : 25165824) + ((size_t)((seq * 2 + e) * 16 + h)) * 64 * 128;
#pragma unroll
            for (int nt = 0; nt < 8; ++nt)
#pragma unroll
                for (int j = 0; j < 4; ++j) o[(size_t)(16 * w + quad * 4 + j) * 128 + nt * 16 + l15] = hst[nt][j];
        }
    }
}

DEVI void phase_mixers(const P& p, int e, char* smem) {
    unsigned* qctr = (unsigned*)(p.ws + OFF_BAR) + 3456 + 64 * e;
    volatile int* s_item = (volatile int*)(smem + LDS_BYTES - 16);
#define QUEUE_LOOP(QI, N, CALL) for (;;) { __syncthreads(); if (threadIdx.x == 0) *s_item = (int)atomicAdd(qctr + (QI) * 16, 1u); __syncthreads(); \
        const int it = __builtin_amdgcn_readfirstlane(*s_item); if (it >= (N)) break; CALL; }
    QUEUE_LOOP(0, 640, ssd_item(p, e, it, smem))
    QUEUE_LOOP(1, 1024, attn_item(p, e, it, smem))
    {
        const int lane = threadIdx.x & 63, wib = threadIdx.x >> 6;
        const int la = e == 0 ? 1 : 3, na = 4736, nb = e == 0 ? 8384 : 0;
        QUEUE_LOOP(2, (na + nb + 15) >> 4, {
            for (int q = 0; q < 4; ++q) { const int wi = it * 16 + q * 4 + wib;
                if (wi < na) cvt_layer_item(p, la, wi, lane); else if (wi < na + nb) cvt_layer_item(p, 2, wi - na, lane); } })
    }
}

DEVI void phase_combine(const P& p, int e) {
    char* ws = p.ws;
    const int lane = threadIdx.x & 63, gw = blockIdx.x * 4 + (threadIdx.x >> 6), nw = gridDim.x * 4;
    const bf16_t* YF = (const bf16_t*)(ws + OFF_YF); const bf16_t* YB = (const bf16_t*)(ws + OFF_YB);
    const bf16_t* XC = (const bf16_t*)(ws + OFF_XBCC); const bf16_t* Z = (const bf16_t*)(ws + OFF_Z);
    bf16_t* OC = (bf16_t*)(ws + OFF_OCAT);
    const float* dsk = p.d_skip + e * 16; const float* gn = p.ssd_norm + e * 1024;
    for (int r0 = gw * 2; r0 < T_ALL; r0 += nw * 2) {
        uint4 yf[2][2], yb[2][2], xs[2][2], zz[2][2];
#pragma unroll
        for (int q = 0; q < 2; ++q)
#pragma unroll
            for (int i = 0; i < 2; ++i) {
                const int c = (lane + i * 64) * 8; const size_t r = r0 + q;
                yf[q][i] = *(const uint4*)(YF + r * 1024 + c); yb[q][i] = *(const uint4*)(YB + r * 1024 + c);
                xs[q][i] = *(const uint4*)(XC + r * 2048 + c); zz[q][i] = *(const uint4*)(Z + r * 1024 + c);
            }
        float v[2][16]; float ss[2];
#pragma unroll
        for (int q = 0; q < 2; ++q) {
            float s_ = 0.f;
#pragma unroll
            for (int i = 0; i < 2; ++i) {
                const int c = (lane + i * 64) * 8;
                const float dk = dsk[c >> 6];
                const unsigned yfa[4] = {yf[q][i].x, yf[q][i].y, yf[q][i].z, yf[q][i].w}, yba[4] = {yb[q][i].x, yb[q][i].y, yb[q][i].z, yb[q][i].w};
                const unsigned xsa[4] = {xs[q][i].x, xs[q][i].y, xs[q][i].z, xs[q][i].w}, za[4] = {zz[q][i].x, zz[q][i].y, zz[q][i].z, zz[q][i].w};
#pragma unroll
                for (int k = 0; k < 4; ++k) {
                    const float y0 = __uint_as_float(yfa[k] << 16) + __uint_as_float(yba[k] << 16) + dk * __uint_as_float(xsa[k] << 16);
                    const float y1 = __uint_as_float(yfa[k] & 0xffff0000u) + __uint_as_float(yba[k] & 0xffff0000u) + dk * __uint_as_float(xsa[k] & 0xffff0000u);
                    const float g0 = y0 * siluf(__uint_as_float(za[k] << 16)), g1 = y1 * siluf(__uint_as_float(za[k] & 0xffff0000u));
                    v[q][i * 8 + k * 2] = g0; v[q][i * 8 + k * 2 + 1] = g1; s_ += g0 * g0 + g1 * g1;
                }
            }
            ss[q] = s_;
        }
#pragma unroll
        for (int o = 32; o > 0; o >>= 1) { ss[0] += __shfl_xor(ss[0], o); ss[1] += __shfl_xor(ss[1], o); }
#pragma unroll
        for (int q = 0; q < 2; ++q) {
            const float rstd = rsqrtf(ss[q] * (1.f / 1024.f) + 1e-6f);
#pragma unroll
            for (int i = 0; i < 2; ++i) {
                const int c = (lane + i * 64) * 8;
                const float4 g0 = *(const float4*)(gn + c), g1 = *(const float4*)(gn + c + 4);
                uint4 o; o.x = pack2(v[q][i * 8 + 0] * rstd * g0.x, v[q][i * 8 + 1] * rstd * g0.y); o.y = pack2(v[q][i * 8 + 2] * rstd * g0.z, v[q][i * 8 + 3] * rstd * g0.w);
                o.z = pack2(v[q][i * 8 + 4] * rstd * g1.x, v[q][i * 8 + 5] * rstd * g1.y); o.w = pack2(v[q][i * 8 + 6] * rstd * g1.z, v[q][i * 8 + 7] * rstd * g1.w);
                *(uint4*)(OC + (size_t)(r0 + q) * 2048 + c) = o;
            }
        }
    }
}

DEVI void phase_inproj(const P& p, int e, char* smem) {
    const bf16_t* A = (const bf16_t*)(p.ws + OFF_HBF); const bf16_t* Bt = (const bf16_t*)(p.ws + OFF_WTIN) + (size_t)e * NIN * 1024;
    bool pre = false;
    for (int t = blockIdx.x; t < 64 * 49; t += gridDim.x) {
        const int m0 = (t & 63) * 128, n0 = (t >> 6) * 128, tn = t + gridDim.x; const bool nx = tn < 64 * 49;
        EpiInProj ep{&p, e, m0, n0};
        gemm_tile(A + (size_t)m0 * 1024, 1024, Bt + (size_t)n0 * 1024, 1024, 1024, smem, ep,
                  nx ? A + (size_t)(tn & 63) * 128 * 1024 : nullptr, nx ? Bt + (size_t)(tn >> 6) * 128 * 1024 : nullptr, pre);
        pre = nx;
    }
}
DEVI void phase_resid_gemm(const P& p, const bf16_t* A, int lda, const bf16_t* Bt, int K, const float* gate, const float* bias, char* smem) {
    float* X = (float*)(p.ws + OFF_X);
    for (int t = blockIdx.x; t < 64 * 8; t += gridDim.x) {
        const int m0 = (t & 63) * 128, n0 = (t >> 6) * 128;
        EpiResid ep{X, gate, bias, m0, n0};
        gemm_tile(A + (size_t)m0 * lda, lda, Bt + (size_t)n0 * K, K, K, smem, ep);
    }
}
DEVI void phase_ffn_in(const P& p, int l, char* smem) {
    const bf16_t* A = (const bf16_t*)(p.ws + OFF_HBF); const bf16_t* Bt = (const bf16_t*)(p.ws + OFF_WTFIN) + (size_t)l * 5632 * 1024;
    bool pre = false;
    for (int t = blockIdx.x; t < 64 * 44; t += gridDim.x) {
        const int m0 = (t & 63) * 128, jt = t >> 6, tn = t + gridDim.x; const bool nx = tn < 64 * 44;
        EpiSwiglu ep{(bf16_t*)(p.ws + OFF_HID), m0, jt};
        gemm_tile(A + (size_t)m0 * 1024, 1024, Bt + (size_t)jt * 128 * 1024, 1024, 1024, smem, ep,
                  nx ? A + (size_t)(tn & 63) * 128 * 1024 : nullptr, nx ? Bt + (size_t)(tn >> 6) * 128 * 1024 : nullptr, pre);
        pre = nx;
    }
}
DEVI void phase_dftc(const P& p, char* smem) {
    const bf16_t* A = (const bf16_t*)(p.ws + OFF_HBF); const bf16_t* Bt = (const bf16_t*)(p.ws + OFF_DC);
    for (int t = blockIdx.x; t < 64 * 16; t += gridDim.x) {
        const int m0 = (t & 63) * 128, gn = t >> 6, g = gn >> 2, nn0 = (gn & 3) * 128;
        EpiDftC ep;
        if (m0 < 4096) { ep.UVt = (bf16_t*)(p.ws + OFF_UVTP) + (size_t)(m0 >> 8) * 1024 * 512; ep.L = 256; ep.tbase = m0 & 255; }
        else { ep.UVt = (bf16_t*)(p.ws + OFF_UVTS) + (size_t)((m0 - 4096) >> 10) * 1024 * 2048; ep.L = 1024; ep.tbase = (m0 - 4096) & 1023; }
        ep.g = g; ep.nn0 = nn0;
        gemm_tile(A + (size_t)m0 * 1024 + g * 256, 1024, Bt + (size_t)nn0 * 256, 256, 256, smem, ep);
    }
}
DEVI void phase_dftl(const P& p, char* smem) {
    bf16_t* F = (bf16_t*)(p.ws + OFF_F);
    for (int t = blockIdx.x; t < 512; t += gridDim.x) {
        const bf16_t* A; const bf16_t* Bt; int K2, row0, nt;
        if (t < 256) {
            const int s = t >> 6, mt = (t >> 3) & 7; nt = t & 7; K2 = 2048; row0 = 4096 + s * 1024 + mt * 128;
            A = (const bf16_t*)(p.ws + OFF_DL1024) + (size_t)mt * 128 * 2048; Bt = (const bf16_t*)(p.ws + OFF_UVTS) + ((size_t)s * 1024 + nt * 128) * 2048;
        } else {
            const int i2 = t - 256, b = i2 >> 4, mt = (i2 >> 3) & 1; nt = i2 & 7; K2 = 512; row0 = b * 256 + mt * 128;
            A = (const bf16_t*)(p.ws + OFF_DL256) + (size_t)mt * 128 * 512; Bt = (const bf16_t*)(p.ws + OFF_UVTP) + ((size_t)b * 1024 + nt * 128) * 512;
        }
        EpiBf16 ep{F, 1024, row0, nt * 128};
        gemm_tile(A, K2, Bt, K2, K2, smem, ep);
    }
}

#define XB_TMO      128
#define XB_XCNT(j)  (256  + 64 * (j))
#define XB_XSUB(j)  (1280 + 64 * (j))
#define XB_XGEN(j)  (2304 + 64 * (j))
#define XB_TOP      3328
#define XB_TOPGEN   3392
#define XCD_BAR_WORDS 3456
#define XB_SPIN_CAP (1u << 22)
DEVI unsigned xb_ld(unsigned* p)              { return __hip_atomic_load(p, __ATOMIC_RELAXED, __HIP_MEMORY_SCOPE_AGENT); }
DEVI unsigned xb_add(unsigned* p, unsigned v) { return __hip_atomic_fetch_add(p, v, __ATOMIC_RELAXED, __HIP_MEMORY_SCOPE_AGENT); }
DEVI unsigned xb_xcc_id() { return (unsigned)__builtin_amdgcn_s_getreg((3 << 11) | 20) & 0xFu; }
#define XB_SPIN(cond, bar) do { unsigned _sp = 0; while (cond) { __builtin_amdgcn_s_sleep(1); \
    if ((++_sp & 255u) == 0u) { if (xb_ld(&(bar)[XB_TMO])) break; if (_sp > XB_SPIN_CAP) { atomicAdd(&(bar)[XB_TMO], 1u); break; } } } } while (0)
struct XcdBarrier { unsigned* bar; unsigned x; volatile LAS unsigned* st; };
DEVI XcdBarrier xcd_barrier_post(unsigned* bar, volatile LAS unsigned* st) {
    XcdBarrier b; b.bar = bar; b.x = xb_xcc_id(); b.st = st;
    if (threadIdx.x == 0) (void)xb_add(&bar[XB_XCNT(b.x)], 1u);
    return b;
}
DEVI void xcd_barrier_complete(unsigned* bar, unsigned x, unsigned& nloc, unsigned& nx) {
    const unsigned G = gridDim.x * gridDim.y * gridDim.z;
    unsigned sum, cnt, mine, sp = 0u;
    for (;;) {
        sum = 0u; cnt = 0u; mine = 0u;
#pragma unroll
        for (unsigned j = 0; j < 16; ++j) { const unsigned c = xb_ld(&bar[XB_XCNT(j)]); sum += c; cnt += (c > 0u) ? 1u : 0u; mine = (j == x) ? c : mine; }
        if (sum == G) break;
        __builtin_amdgcn_s_sleep(1);
        if ((++sp & 255u) == 0u) { if (xb_ld(&bar[XB_TMO])) break; if (sp > XB_SPIN_CAP) { atomicAdd(&bar[XB_TMO], 1u); break; } }
    }
    nloc = mine > 0u ? mine : 1u; nx = cnt > 0u ? cnt : 1u;
}
DEVI void xcd_barrier(const XcdBarrier& b) {
    asm volatile("s_waitcnt vmcnt(0)" ::: "memory");
    __syncthreads();
    if (threadIdx.x == 0) {
        unsigned* bar = b.bar;
        __builtin_amdgcn_s_waitcnt(0);
        unsigned nloc = b.st[0], nx = b.st[1];
        if (nloc == 0u) { xcd_barrier_complete(bar, b.x, nloc, nx); b.st[0] = nloc; b.st[1] = nx; }
        const unsigned old = xb_add(&bar[XB_XSUB(b.x)], 1u);
        const unsigned gen = old / nloc;
        if (old + 1u == (gen + 1u) * nloc) {
            __builtin_amdgcn_fence(__ATOMIC_RELEASE, "agent");
            asm volatile("s_waitcnt vmcnt(0)" ::: "memory");
            const unsigned og = xb_add(&bar[XB_TOP], 1u);
            const unsigned tg = og / nx;
            if (og + 1u == (tg + 1u) * nx) xb_add(&bar[XB_TOPGEN], 1u);
            else XB_SPIN(xb_ld(&bar[XB_TOPGEN]) == tg, bar);
            __builtin_amdgcn_fence(__ATOMIC_ACQUIRE, "agent");
            xb_add(&bar[XB_XGEN(b.x)], 1u);
            asm volatile("s_waitcnt vmcnt(0)" ::: "memory");
        } else {
            XB_SPIN(xb_ld(&bar[XB_XGEN(b.x)]) == gen, bar);
            __builtin_amdgcn_fence(__ATOMIC_ACQUIRE, "agent");
            asm volatile("s_waitcnt vmcnt(0)" ::: "memory");
        }
    }
    __syncthreads();
}

DEVI void run_phase(const P& p, int ph, char* smem) {
    if (ph == 0) { phase_pre(p, smem); return; }
    if (ph == 33) { phase_norm(p, 0, 2); return; }
    int q = ph - 1, l;
    if (q < 9) l = 0; else if (q < 16) { l = 1; q -= 9; } else if (q < 25) { l = 2; q -= 16; } else { l = 3; q -= 25; }
    const float* MODl = (const float*)(p.ws + OFF_MOD) + (size_t)l * 5 * 6144;
    int f;
    if ((l & 1) == 0) {
        const int e = l >> 1;
        f = q - 6;
        switch (q) {
            case 0: phase_norm(p, l, 0); phase_ctx(p, e); break;
            case 1: phase_inproj(p, e, smem); break;
            case 2: phase_conv(p, e); break;
            case 3: phase_mixers(p, e, smem); break;
            case 4: phase_combine(p, e); break;
            case 5: phase_resid_gemm(p, (const bf16_t*)(p.ws + OFF_OCAT), 2048, (const bf16_t*)(p.ws + OFF_WTOUT) + (size_t)e * 1024 * 2048, 2048, MODl + 2048, nullptr, smem); break;
            default: break;
        }
    } else {
        const int o = l >> 1;
        f = q - 4;
        switch (q) {
            case 0: phase_norm(p, l, 0); break;
            case 1: phase_dftc(p, smem); break;
            case 2: phase_dftl(p, smem); break;
            case 3: phase_resid_gemm(p, (const bf16_t*)(p.ws + OFF_F), 1024, (const bf16_t*)(p.ws + OFF_WTFOUR) + (size_t)o * 1024 * 1024, 1024, MODl + 2048, p.b_four + o * 1024, smem); break;
            default: break;
        }
    }
    if (f == 0) phase_norm(p, l, 1);
    else if (f == 1) phase_ffn_in(p, l, smem);
    else if (f == 2) phase_resid_gemm(p, (const bf16_t*)(p.ws + OFF_HID), FH, (const bf16_t*)(p.ws + OFF_WTFOUT) + (size_t)l * 1024 * 2816, FH, MODl + 5120, nullptr, smem);
}

typedef const __attribute__((address_space(4))) P* KP;
DEVI const P& kargs() { KP k = (KP)__builtin_amdgcn_kernarg_segment_ptr(); asm volatile("" : "+s"(k)); return *(const P*)k; }

#ifndef PROBE_CLASS
#define PROBE_CLASS -1
#endif
constexpr int phase_class(int ph) {
    if (ph == 0) return 0;
    if (ph == 33) return 1;
    int q = ph - 1; bool even = true;
    if (q < 9) {} else if (q < 16) { even = false; q -= 9; } else if (q < 25) { q -= 16; } else { even = false; q -= 25; }
    if (even) { constexpr int t[9] = {1, 2, 3, 4, 5, 6, 1, 7, 6}; return t[q]; }
    constexpr int t[7] = {1, 8, 9, 6, 1, 7, 6}; return t[q];
}
template <bool COOP, int PH> struct Seq {
    static DEVI void run(const XcdBarrier& xb, char* smem, int lo, int hi) {
        if (PH >= lo && PH <= hi) {
            if (phase_class(PH) == PROBE_CLASS) run_phase(kargs(), PH, smem);
            run_phase(kargs(), PH, smem);
            if (COOP) { if (PH < hi) { xcd_barrier(xb); if (PROBE_CLASS == 100) { xcd_barrier(xb); xcd_barrier(xb); } } }
        }
        Seq<COOP, PH + 1>::run(xb, smem, lo, hi);
    }
};
template <bool COOP> struct Seq<COOP, NPHASE> { static DEVI void run(const XcdBarrier&, char*, int, int) {} };

template <bool COOP>
__global__ void __launch_bounds__(256, 2) mega(P p, int ph_lo, int ph_hi) {
    __shared__ __attribute__((aligned(16))) char smem[LDS_BYTES];
    __shared__ uint4 xb_words;
    XcdBarrier xb{};
    if (COOP) {
        if (threadIdx.x == 0) xb_words = make_uint4(0u, 0u, 0u, 0u);
        __syncthreads();
        xb = xcd_barrier_post((unsigned*)(kargs().ws + OFF_BAR), (volatile LAS unsigned*)&xb_words);
        if (ph_lo < 0) cg::this_grid().sync();
    }
    Seq<COOP, 0>::run(xb, smem, ph_lo, ph_hi);
}

extern "C" void kernel_launch(void* const* d_in, const int* in_sizes, int n_in, void* d_out, int out_size, void* d_ws, size_t ws_size, hipStream_t stream) {
    P p{};
    const float** pp = (const float**)&p;
    for (int i = 0; i < 27; ++i) pp[i] = (const float*)d_in[i];
    p.out = (float*)d_out; p.ws = (char*)d_ws;
    if (ws_size < WS_END) { fprintf(stderr, "workspace too small: %zu < %zu\n", ws_size, (size_t)WS_END); return; }
    static int grid_blocks = 0;
    if (!grid_blocks) {
        int dev = 0, cus = 0, per_cu = 0;
        hipGetDevice(&dev);
        hipDeviceGetAttribute(&cus, hipDeviceAttributeMultiprocessorCount, dev);
        hipOccupancyMaxActiveBlocksPerMultiprocessor(&per_cu, mega<true>, 256, 0);
        if (per_cu > 2) per_cu = 2;
        if (per_cu < 1) per_cu = 1;
        grid_blocks = cus * per_cu;
    }
    hipMemsetAsync((char*)d_ws + OFF_BAR, 0, 16384, stream);
    int lo = 0, hi = NPHASE - 1;
    void* args[] = {&p, &lo, &hi};
    hipError_t err = hipLaunchCooperativeKernel((void*)mega<true>, dim3(grid_blocks), dim3(256), args, 0, stream);
    if (err != hipSuccess) fprintf(stderr, "cooperative launch failed: %s (grid %d)\n", hipGetErrorString(err), grid_blocks);

}
```
